# Optimizing an MI355X kernel written in HIP

```python
import jax
import jax.numpy as jnp
from jax import lax
import numpy as np

D_MODEL = 4096
BATCH = 4
SEQ = 4096
DEPTH = 2

GRID_W = 64
EPS = 1e-6
A_HEADS = 8
A_WIDTH = D_MODEL
A_V_DIM = A_WIDTH // A_HEADS
A_QK_DIM = A_V_DIM // 2
A_QK_WIDTH = A_HEADS * A_QK_DIM
A_CONV_W = 3
MLSTM_CHUNK = 128
B_WIDTH = D_MODEL
B_HEAD_DIM = 128
B_HEADS = B_WIDTH // B_HEAD_DIM
NA_WIN_R = 8
NA_WIN_C = 16
C_WIDTH = 2 * D_MODEL
C_GROUPS = 8
C_CHUNK = 128
LAYER0_SPLITS = (A_QK_WIDTH, A_QK_WIDTH, A_WIDTH, A_WIDTH, A_WIDTH, 4 * A_HEADS, B_WIDTH, B_WIDTH, B_WIDTH, B_WIDTH)
LAYER0_COLS = 2 * A_QK_WIDTH + 3 * A_WIDTH + 4 * A_HEADS + 4 * B_WIDTH

kernel_name = 'hybrid_mlstm_natten_gmlp_encoder'


def rms_norm(x, g):
    xf = x.astype(jnp.float32)
    y = xf * lax.rsqrt(jnp.mean(xf * xf, axis=-1, keepdims=True) + EPS)
    return (y * g.astype(jnp.float32)).astype(x.dtype)


def modulation(c, w_ada, b_ada):
    mod = jax.nn.silu(c) @ w_ada + b_ada
    shift, scale, gate = jnp.split(mod, 3, axis=-1)
    return shift[:, None, :], scale[:, None, :], gate[:, None, :]


def centred_dwconv(x, w):
    taps = w.shape[0]
    pad = taps // 2
    seq = x.shape[1]
    xp = jnp.pad(x, ((0, 0), (pad, pad), (0, 0)))
    y = xp[:, 0:seq] * w[0]
    for j in range(1, taps):
        y = y + xp[:, j:j + seq] * w[j]
    return y


def mlstm_one_direction(q, k, v, ig, lf):
    bsz, nh, seq, dk = q.shape
    dv = v.shape[-1]
    L = MLSTM_CHUNK
    nc = seq // L

    def to_chunks(a):
        a = a.reshape(bsz, nh, nc, L, *a.shape[3:])
        return jnp.moveaxis(a, 2, 0)

    xs = (to_chunks(q), to_chunks(k), to_chunks(v), to_chunks(ig), to_chunks(lf))
    tril = jnp.tril(jnp.ones((L, L), dtype=bool))

    def step(carry, chunk):
        C, n, m = carry
        qc, kc, vc, igc, lfc = chunk
        g = jnp.cumsum(lfc, axis=-1)
        D = g[..., :, None] - g[..., None, :] + igc[..., None, :]
        D = jnp.where(tril, D, -jnp.inf)
        m_t = jnp.maximum(g + m[..., None], jnp.max(D, axis=-1))
        P = jnp.exp(D - m_t[..., None])
        inter = jnp.exp(g + m[..., None] - m_t)
        S_ = jnp.einsum('bhtd,bhsd->bhts', qc, kc) * P
        num = jnp.einsum('bhts,bhsv->bhtv', S_, vc) + inter[..., None] * jnp.einsum('bhtd,bhdv->bhtv', qc, C)
        den = jnp.sum(S_, axis=-1) + inter * jnp.einsum('bhtd,bhd->bht', qc, n)
        h = num / jnp.maximum(jnp.abs(den), jnp.exp(-m_t))[..., None]
        gL = g[..., -1]
        ds = gL[..., None] - g + igc
        m_new = jnp.maximum(gL + m, jnp.max(ds, axis=-1))
        w = jnp.exp(ds - m_new[..., None])
        decay = jnp.exp(gL + m - m_new)
        C_new = decay[..., None, None] * C + jnp.einsum('bhs,bhsd,bhsv->bhdv', w, kc, vc)
        n_new = decay[..., None] * n + jnp.einsum('bhs,bhsd->bhd', w, kc)
        return (C_new, n_new, m_new), h

    init = (jnp.zeros((bsz, nh, dk, dv), jnp.float32),
            jnp.zeros((bsz, nh, dk), jnp.float32),
            jnp.zeros((bsz, nh), jnp.float32))
    _, h = lax.scan(step, init, xs)
    return jnp.moveaxis(h, 0, 2).reshape(bsz, nh, seq, dv)


def mlstm_mixer(a_q, a_k, a_v, a_o, a_gates, a_conv_w, a_gate_b, a_norm_g):
    bsz, seq, _ = a_v.shape
    qk = jax.nn.silu(centred_dwconv(jnp.concatenate([a_q, a_k], axis=-1), a_conv_w))

    def heads(t, d):
        return t.reshape(bsz, seq, A_HEADS, d).transpose(0, 2, 1, 3).astype(jnp.float32)

    q = heads(qk[..., :A_QK_WIDTH], A_QK_DIM) * (A_QK_DIM ** -0.5)
    k = heads(qk[..., A_QK_WIDTH:], A_QK_DIM)
    v = heads(a_v, A_V_DIM)
    g = (a_gates.astype(jnp.float32) + a_gate_b.astype(jnp.float32)).reshape(bsz, seq, 4, A_HEADS).transpose(2, 0, 3, 1)
    h_f = mlstm_one_direction(q, k, v, g[0], jax.nn.log_sigmoid(g[1]))
    fl = lambda t: jnp.flip(t, axis=2)
    h_b = fl(mlstm_one_direction(fl(q), fl(k), fl(v), fl(g[2]), fl(jax.nn.log_sigmoid(g[3]))))
    h = (h_f + h_b).transpose(0, 2, 1, 3)
    h = rms_norm(h, a_norm_g).reshape(bsz, seq, A_WIDTH).astype(a_v.dtype)
    return jax.nn.sigmoid(a_o) * h


def neighbourhood_attention(q, k, v, q_gain, k_gain, rpb):
    bsz, seq, _ = q.shape
    rows = seq // GRID_W
    win_r = min(NA_WIN_R, rows)

    def to_grid(a):
        return a.reshape(bsz, rows, GRID_W, B_HEADS, B_HEAD_DIM).transpose(0, 3, 1, 2, 4)

    q = rms_norm(q.reshape(bsz, seq, B_HEADS, B_HEAD_DIM), q_gain) * (B_HEAD_DIM ** -0.5)
    k = rms_norm(k.reshape(bsz, seq, B_HEADS, B_HEAD_DIM), k_gain)
    qg = jnp.moveaxis(to_grid(q), 2, 0)
    kg = to_grid(k)
    vg = to_grid(v)
    qc = jnp.arange(GRID_W)
    cs = jnp.clip(qc - NA_WIN_C // 2, 0, GRID_W - NA_WIN_C)
    col_mask = (qc[None, :] >= cs[:, None]) & (qc[None, :] < cs[:, None] + NA_WIN_C)
    dc_idx = jnp.clip(qc[None, :] - qc[:, None] + NA_WIN_C - 1, 0, 2 * NA_WIN_C - 2)

    def row_block(args):
        r, q_r = args
        rs = jnp.clip(r - win_r // 2, 0, rows - win_r)
        k_r = lax.dynamic_slice_in_dim(kg, rs, win_r, axis=2)
        v_r = lax.dynamic_slice_in_dim(vg, rs, win_r, axis=2)
        s = jnp.einsum('bhqd,bhjkd->bhqjk', q_r, k_r).astype(jnp.float32)
        dr = rs + jnp.arange(win_r) - r + NA_WIN_R - 1
        bias = rpb[:, dr[None, :, None], dc_idx[:, None, :]]
        s = jnp.where(col_mask[:, None, :], s + bias.astype(jnp.float32), -jnp.inf)
        p = jax.nn.softmax(s, axis=(-2, -1)).astype(v_r.dtype)
        return jnp.einsum('bhqjk,bhjkd->bhqd', p, v_r)

    out = lax.map(row_block, (jnp.arange(rows), qg))
    return out.transpose(1, 0, 3, 2, 4).reshape(bsz, seq, B_WIDTH)


def even_mixer(h, w_in0, a_conv_w, a_gate_b, a_norm_g, b_q_gain, b_k_gain, b_rpb, w_out0):
    proj = h @ w_in0
    offsets = np.cumsum(np.array(LAYER0_SPLITS))[:-1].tolist()
    a_q, a_k, a_v, a_o, a_z, a_gates, b_q, b_k, b_v, b_z = jnp.split(proj, offsets, axis=-1)
    y_a = mlstm_mixer(a_q, a_k, a_v, a_o, a_gates, a_conv_w, a_gate_b, a_norm_g) * jax.nn.silu(a_z)
    y_b = neighbourhood_attention(b_q, b_k, b_v, b_q_gain, b_k_gain, b_rpb) * jax.nn.silu(b_z)
    return jnp.concatenate([y_a, y_b], axis=-1) @ w_out0


def odd_mixer(h, w_in1, c_v_norm_g, c_w_s, c_b_s, w_out1):
    bsz, seq, _ = h.shape
    u, v, z = jnp.split(h @ w_in1, 3, axis=-1)
    u = jax.nn.gelu(u)
    v = rms_norm(jax.nn.gelu(v), c_v_norm_g)
    v = v.reshape(bsz, seq // C_CHUNK, C_CHUNK, C_GROUPS, C_WIDTH // C_GROUPS)
    sv = jnp.einsum('gts,bnsgc->bntgc', c_w_s, v) + c_b_s.T[:, :, None]
    y = u * sv.reshape(bsz, seq, C_WIDTH) * jax.nn.silu(z)
    return y @ w_out1


def setup_inputs(seed: int = 0) -> dict:
    key = jax.random.key(seed)
    ks = jax.random.split(key, 24)
    nrm = lambda k, shape, scale: jax.random.normal(k, shape, jnp.float32) * scale
    D = D_MODEL
    fg_bias = jnp.linspace(3.0, 6.0, A_HEADS, dtype=jnp.float32)
    a_gate_b = jnp.concatenate([
        nrm(ks[7], (A_HEADS,), 0.1),
        fg_bias + nrm(ks[8], (A_HEADS,), 0.1),
        nrm(ks[9], (A_HEADS,), 0.1),
        fg_bias + nrm(ks[10], (A_HEADS,), 0.1)])
    return {
        'x': nrm(ks[0], (BATCH, SEQ, D), 1.0),
        'c': nrm(ks[1], (BATCH, D), 1.0),
        'norm_g0': 1.0 + nrm(ks[2], (D,), 0.02),
        'ada_w0': nrm(ks[3], (D, 3 * D), D ** -0.5),
        'ada_b0': nrm(ks[4], (3 * D,), 0.02),
        'w_in0': nrm(ks[5], (D, LAYER0_COLS), D ** -0.5),
        'a_conv_w': nrm(ks[6], (A_CONV_W, 2 * A_QK_WIDTH), A_CONV_W ** -0.5),
        'a_gate_b': a_gate_b,
        'a_norm_g': 1.0 + nrm(ks[11], (A_HEADS, A_V_DIM), 0.02),
        'b_q_gain': 1.0 + nrm(ks[12], (B_HEAD_DIM,), 0.02),
        'b_k_gain': 1.0 + nrm(ks[13], (B_HEAD_DIM,), 0.02),
        'b_rpb': nrm(ks[14], (B_HEADS, 2 * NA_WIN_R - 1, 2 * NA_WIN_C - 1), 0.1),
        'w_out0': nrm(ks[15], (A_WIDTH + B_WIDTH, D), (A_WIDTH + B_WIDTH) ** -0.5),
        'norm_g1': 1.0 + nrm(ks[16], (D,), 0.02),
        'ada_w1': nrm(ks[17], (D, 3 * D), D ** -0.5),
        'ada_b1': nrm(ks[18], (3 * D,), 0.02),
        'w_in1': nrm(ks[19], (D, 3 * C_WIDTH), D ** -0.5),
        'c_v_norm_g': 1.0 + nrm(ks[20], (C_WIDTH,), 0.02),
        'c_w_s': nrm(ks[21], (C_GROUPS, C_CHUNK, C_CHUNK), C_CHUNK ** -0.5),
        'c_b_s': 1.0 + nrm(ks[22], (C_GROUPS, C_CHUNK), 0.02),
        'w_out1': nrm(ks[23], (C_WIDTH, D), C_WIDTH ** -0.5),
    }


def reference(x, c, norm_g0, ada_w0, ada_b0, w_in0, a_conv_w, a_gate_b, a_norm_g, b_q_gain, b_k_gain, b_rpb, w_out0,
              norm_g1, ada_w1, ada_b1, w_in1, c_v_norm_g, c_w_s, c_b_s, w_out1):
    norm_gs = (norm_g0, norm_g1)
    ada_ws = (ada_w0, ada_w1)
    ada_bs = (ada_b0, ada_b1)
    mixers = (
        lambda h: even_mixer(h, w_in0, a_conv_w, a_gate_b, a_norm_g, b_q_gain, b_k_gain, b_rpb, w_out0),
        lambda h: odd_mixer(h, w_in1, c_v_norm_g, c_w_s, c_b_s, w_out1),
    )
    for layer in range(DEPTH):
        shift, scale, gate = modulation(c, ada_ws[layer], ada_bs[layer])
        h = rms_norm(x, norm_gs[layer]) * (1.0 + scale) + shift
        x = x + gate * mixers[layer % 2](h)
    return x
```

```cpp
#include <hip/hip_runtime.h>
#include <cstdio>
#include <cstdint>
#include <type_traits>
#define LAS __attribute__((address_space(3)))
namespace pg8 {
#define PG8_LAS __attribute__((address_space(3)))
typedef unsigned short bf16_t;
typedef short bf16x8 __attribute__((ext_vector_type(8)));
typedef float f32x4 __attribute__((ext_vector_type(4)));
typedef unsigned u32x4 __attribute__((ext_vector_type(4)));
constexpr int BM = 256, BK = 64, HALF = 128, HTB = HALF * BK * 2  , STAGE_BYTES = 8 * HTB, NXCD = 8, WGM = 8;

__host__ __device__ __forceinline__ int lds_byte(int r, int c) { const int st = (r >> 4) * 2 + (c >> 5), rr = r & 15, cc = c & 31, ob = rr * 64 + cc * 2; return st * 1024 + (ob ^ (((ob >> 9) & 1) << 5)); }
__host__ __device__ __forceinline__ void stage_rc(int b, int& R, int& C) { const int st = b / 1024, sb = b % 1024, swz = sb ^ (((sb >> 9) & 1) << 5); R = (st >> 1) * 16 + swz / 64; C = (st & 1) * 32 + (swz % 64) / 2; }
__host__ __device__ __forceinline__ int perm32(int rho) { const int n = rho >> 4, i = rho & 15; return 8 * (i >> 2) + 4 * n + (i & 3); }

struct Unit { int pm, pn; };
struct Gemm { const bf16_t* A; const bf16_t* Bt; int M, N, K; };

struct StaticOrder {
    int nM, nN, nwg, G, c;
    __host__ __device__ void init(int M, int N, int G_, int c_) { nM = M / BM; nN = N / BM; nwg = nM * nN; G = G_; c = c_; }
    __host__ __device__ bool next(int i, Unit& u) const {
        const long L = (long)i * G + c; if (L >= nwg) return false;
        int wgid = (int)L; { const int q = nwg / NXCD, r = nwg % NXCD, xcd = wgid % NXCD, off = wgid / NXCD; wgid = (xcd < r ? xcd * (q + 1) : r * (q + 1) + (xcd - r) * q) + off; }
        const int nig = WGM * nN, gid = wgid / nig, fm = gid * WGM, gsz = (nM - fm) < WGM ? (nM - fm) : WGM;
        u.pm = fm + ((wgid % nig) % gsz); u.pn = (wgid % nig) / gsz; return true;
    }
    __device__ __forceinline__ void a_ready(const Unit&) const {}
    __device__ __forceinline__ void done(const Unit&) const {}
};
struct HybridOrder : StaticOrder {
    int ns; unsigned* head; volatile PG8_LAS int* slot;
    __device__ __forceinline__ bool next(int i, Unit& u) const {
        if (i < ns) return StaticOrder::next(i, u);
        if (threadIdx.x == 0) { const unsigned t = __hip_atomic_fetch_add(head, 1u, __ATOMIC_RELAXED, __HIP_MEMORY_SCOPE_AGENT); slot[i & 1] = (int)t; }
        asm volatile("s_waitcnt lgkmcnt(0)" ::: "memory"); __builtin_amdgcn_s_barrier(); asm volatile("" ::: "memory");
        const long L = (long)ns * G + slot[i & 1]; if (L >= nwg) return false;
        int wgid = (int)L; { const int q = nwg / NXCD, r = nwg % NXCD, xcd = wgid % NXCD, off = wgid / NXCD; wgid = (xcd < r ? xcd * (q + 1) : r * (q + 1) + (xcd - r) * q) + off; }
        const int nig = WGM * nN, gid = wgid / nig, fm = gid * WGM, gsz = (nM - fm) < WGM ? (nM - fm) : WGM;
        u.pm = fm + ((wgid % nig) % gsz); u.pn = (wgid % nig) / gsz; return true;
    }
};
__device__ __forceinline__ unsigned cvt_pk_bf16(float lo, float hi) { unsigned r; asm volatile("v_cvt_pk_bf16_f32 %0, %1, %2" : "=v"(r) : "v"(lo), "v"(hi)); return r; }
typedef float f32x2 __attribute__((ext_vector_type(2)));
__device__ __forceinline__ float act_sigm(float x) { return __builtin_amdgcn_rcpf(1.0f + __builtin_amdgcn_exp2f(-1.4426950408889634f * x)); }
__device__ __forceinline__ float act_silu(float x) { return x * act_sigm(x); }
__device__ __forceinline__ float act_gelu(float x) { const float y = x * (2.3022081985f + 0.1029432367f * x * x); return x * __builtin_amdgcn_rcpf(1.0f + __builtin_amdgcn_exp2f(-y)); }
template <int ACT> struct EpiStore {
    static constexpr bool PERM = true, AFTER_DRAIN = false;
    bf16_t* O; int ldc;
    __device__ __forceinline__ void operator()(const f32x4 (&acc)[2][2][4][2], const Unit& u, int wr, int wc, int fr, int fq) const {
        const int row0 = u.pm * BM + wr * 64 + fr, col0 = u.pn * BM + wc * 32 + 8 * fq;
#pragma unroll
        for (int ai = 0; ai < 2; ++ai)
#pragma unroll
            for (int m = 0; m < 4; ++m) { bf16_t* rowp = O + (size_t)(row0 + ai * HALF + m * 16) * ldc + col0;
#pragma unroll
                for (int bj = 0; bj < 2; ++bj) { f32x4 v0 = acc[ai][bj][m][0], v1 = acc[ai][bj][m][1];
                    if (ACT == 1) {
#pragma unroll
                        for (int j = 0; j < 4; ++j) { v0[j] = act_silu(v0[j]); v1[j] = act_silu(v1[j]); } }
                    if (ACT == 2) {
#pragma unroll
                        for (int j = 0; j < 4; ++j) { v0[j] = act_gelu(v0[j]); v1[j] = act_gelu(v1[j]); } }
                    u32x4 w; w.x = cvt_pk_bf16(v0[0], v0[1]); w.y = cvt_pk_bf16(v0[2], v0[3]); w.z = cvt_pk_bf16(v1[0], v1[1]); w.w = cvt_pk_bf16(v1[2], v1[3]);
                    *(u32x4*)(rowp + bj * HALF) = w; } }
    }
};
template <int KIND> struct EpiPair {
    static constexpr bool PERM = true, AFTER_DRAIN = false;
    bf16_t* O; int ldc;
    __device__ __forceinline__ void operator()(const f32x4 (&acc)[2][2][4][2], const Unit& u, int wr, int wc, int fr, int fq) const {
        const int row0 = u.pm * BM + wr * 64 + fr, col0 = u.pn * HALF + wc * 32 + 8 * fq;
#pragma unroll
        for (int ai = 0; ai < 2; ++ai)
#pragma unroll
            for (int m = 0; m < 4; ++m) { bf16_t* rowp = O + (size_t)(row0 + ai * HALF + m * 16) * ldc + col0;
                f32x4 r0, r1;
#pragma unroll
                for (int j = 0; j < 4; ++j) {
                    const float p0 = acc[ai][0][m][0][j], p1 = acc[ai][0][m][1][j], z0 = acc[ai][1][m][0][j], z1 = acc[ai][1][m][1][j];
                    r0[j] = (KIND == 0 ? act_sigm(p0) : act_gelu(p0)) * act_silu(z0);
                    r1[j] = (KIND == 0 ? act_sigm(p1) : act_gelu(p1)) * act_silu(z1); }
                u32x4 w; w.x = cvt_pk_bf16(r0[0], r0[1]); w.y = cvt_pk_bf16(r0[2], r0[3]); w.z = cvt_pk_bf16(r1[0], r1[1]); w.w = cvt_pk_bf16(r1[2], r1[3]);
                *(u32x4*)rowp = w; }
    }
};
struct EpiGeluT {
    static constexpr bool PERM = true, AFTER_DRAIN = false;
    bf16_t* O; int ldc; float* SS; int ldss;
    __device__ __forceinline__ void operator()(const f32x4 (&acc)[2][2][4][2], const Unit& u, int wr, int wc, int fr, int fq) const {
        const int row0 = u.pm * BM + wr * 64 + fr, col0 = u.pn * BM + wc * 32 + 8 * fq;
        f32x4 ss[2][2];
#pragma unroll
        for (int bj = 0; bj < 2; ++bj) { ss[bj][0] = (f32x4){0.f, 0.f, 0.f, 0.f}; ss[bj][1] = (f32x4){0.f, 0.f, 0.f, 0.f}; }
#pragma unroll
        for (int ai = 0; ai < 2; ++ai)
#pragma unroll
            for (int m = 0; m < 4; ++m) { bf16_t* rowp = O + (size_t)(row0 + ai * HALF + m * 16) * ldc + col0;
#pragma unroll
                for (int bj = 0; bj < 2; ++bj) { f32x4 v0 = acc[ai][bj][m][0], v1 = acc[ai][bj][m][1];
#pragma unroll
                    for (int j = 0; j < 4; ++j) { v0[j] = act_gelu(v0[j]); v1[j] = act_gelu(v1[j]); }
                    ss[bj][0] += v0 * v0; ss[bj][1] += v1 * v1;
                    u32x4 w; w.x = cvt_pk_bf16(v0[0], v0[1]); w.y = cvt_pk_bf16(v0[2], v0[3]); w.z = cvt_pk_bf16(v1[0], v1[1]); w.w = cvt_pk_bf16(v1[2], v1[3]);
                    *(u32x4*)(rowp + bj * HALF) = w; } }
#pragma unroll
        for (int bj = 0; bj < 2; ++bj)
#pragma unroll
            for (int n = 0; n < 2; ++n)
#pragma unroll
                for (int j = 0; j < 4; ++j) { float s = ss[bj][n][j]; s += __shfl_xor(s, 1); s += __shfl_xor(s, 2); s += __shfl_xor(s, 4); s += __shfl_xor(s, 8); ss[bj][n][j] = s; }
        if (fr == 0) { float* sp = SS + (size_t)(2 * u.pm + wr) * ldss + col0;
#pragma unroll
            for (int bj = 0; bj < 2; ++bj) { *(f32x4*)(sp + bj * HALF) = ss[bj][0]; *(f32x4*)(sp + bj * HALF + 4) = ss[bj][1]; } }
    }
};
template <bool BASE_BF16, bool OUT_BF16> struct EpiResid {
    static constexpr bool PERM = false, AFTER_DRAIN = false;
    const void* base; void* out; int ldc; const float* mod; const float* adab; int rows_per_batch;
    __device__ __forceinline__ void operator()(const f32x4 (&acc)[2][2][4][2], const Unit& u, int wr, int wc, int fr, int fq) const {
        const int row0 = u.pm * BM + wr * 64 + fr, col0 = u.pn * BM + wc * 32 + 4 * fq;
        const int b = (u.pm * BM) / rows_per_batch;
        typedef unsigned u32x2 __attribute__((ext_vector_type(2)));
        f32x4 gv[2][2];
#pragma unroll
        for (int bj = 0; bj < 2; ++bj)
#pragma unroll
            for (int n = 0; n < 2; ++n) gv[bj][n] = *(const f32x4*)(mod + (size_t)b * 3 * ldc + 2 * ldc + col0 + bj * HALF + n * 16) + *(const f32x4*)(adab + 2 * ldc + col0 + bj * HALF + n * 16);
        typedef typename std::conditional<BASE_BF16, u32x2, f32x4>::type bv_t;
        bv_t bA[2][2], bB[2][2];
#define ER_LOAD(B_, k_) do { const size_t off_ = (size_t)(row0 + ((k_) >> 2) * HALF + ((k_) & 3) * 16) * ldc + col0; \
            _Pragma("unroll") for (int bj = 0; bj < 2; ++bj) _Pragma("unroll") for (int n = 0; n < 2; ++n) { const size_t o = off_ + bj * HALF + n * 16; \
                if constexpr (BASE_BF16) B_[bj][n] = *(const bv_t*)((const bf16_t*)base + o); else B_[bj][n] = *(const bv_t*)((const float*)base + o); } \
            __builtin_amdgcn_sched_barrier(0); } while (0)
#define ER_STORE(B_, k_) do { const size_t off_ = (size_t)(row0 + ((k_) >> 2) * HALF + ((k_) & 3) * 16) * ldc + col0; \
            _Pragma("unroll") for (int bj = 0; bj < 2; ++bj) _Pragma("unroll") for (int n = 0; n < 2; ++n) { const size_t o = off_ + bj * HALF + n * 16; f32x4 bs; \
                if constexpr (BASE_BF16) { const u32x2 w = B_[bj][n]; bs = (f32x4){__uint_as_float(w.x << 16), __uint_as_float(w.x & 0xffff0000u), __uint_as_float(w.y << 16), __uint_as_float(w.y & 0xffff0000u)}; } \
                else bs = B_[bj][n]; \
                const f32x4 r = bs + gv[bj][n] * acc[(k_) >> 2][bj][(k_) & 3][n]; \
                if (OUT_BF16) { u32x2 w; w.x = cvt_pk_bf16(r[0], r[1]); w.y = cvt_pk_bf16(r[2], r[3]); *(u32x2*)((bf16_t*)out + o) = w; } \
                else *(f32x4*)((float*)out + o) = r; } \
            __builtin_amdgcn_sched_barrier(0); } while (0)
        ER_LOAD(bA, 0);
        ER_LOAD(bB, 1); ER_STORE(bA, 0);
        ER_LOAD(bA, 2); ER_STORE(bB, 1);
        ER_LOAD(bB, 3); ER_STORE(bA, 2);
        ER_LOAD(bA, 4); ER_STORE(bB, 3);
        ER_LOAD(bB, 5); ER_STORE(bA, 4);
        ER_LOAD(bA, 6); ER_STORE(bB, 5);
        ER_LOAD(bB, 7); ER_STORE(bA, 6);
        ER_STORE(bB, 7);
#undef ER_LOAD
#undef ER_STORE
    }
};

template <class Epi, class Sched, bool ALIGN_EPI = false, bool SP2 = false>
__device__ __forceinline__ void gemm_phase(PG8_LAS unsigned char* lds, const Gemm g, const Sched& S, const Epi& E) {
    const int tid = threadIdx.x, wid = __builtin_amdgcn_readfirstlane(tid >> 6), lane = tid & 63, wr = wid >> 2, wc = wid & 3, fr = lane & 15, fq = lane >> 4;
    const int K = g.K, nt = K / BK;
    unsigned voffA[2], voffB[2];
#pragma unroll
    for (int i = 0; i < 2; ++i) { int R, C; stage_rc(tid * 16 + i * 8192, R, C); const int Rb = Epi::PERM ? ((R & ~31) + perm32(R & 31)) : R;
        voffA[i] = (unsigned)(R * K + C) * 2u; voffB[i] = (unsigned)(Rb * K + C) * 2u; }
    const size_t kstep = (size_t)(BK * 2);
    const size_t hstep = (size_t)HALF * K * 2;
    const size_t tstep = 2 * hstep;
    const unsigned ldsw = (unsigned)wid * 1024u;
    const int aoff = lds_byte(wr * 64 + fr, fq * 8), boff = lds_byte(wc * 32 + fr, fq * 8);
#define PG8_SA(b, h) (((b) * 2 + (h)) * HTB)
#define PG8_SB(b, h) ((4 + (b) * 2 + (h)) * HTB)
#define PG8_STAGE(bufoff, gbase, voff) do { _Pragma("unroll") for (int _i = 0; _i < 2; ++_i) \
        __builtin_amdgcn_global_load_lds((const unsigned*)((const char*)(gbase) + (voff)[_i]), (PG8_LAS unsigned*)(lds + (bufoff) + ldsw + _i * 8192), 16, 0, 0); } while (0)
#define PG8_LDA(dst, b, h) do { _Pragma("unroll") for (int m = 0; m < 4; ++m) _Pragma("unroll") for (int k = 0; k < 2; ++k) dst[m][k] = *(const PG8_LAS bf16x8*)(lds + PG8_SA(b, h) + aoff + m * 2048 + k * 1024); } while (0)
#define PG8_LDB(dst, b, h) do { _Pragma("unroll") for (int n = 0; n < 2; ++n) _Pragma("unroll") for (int k = 0; k < 2; ++k) dst[n][k] = *(const PG8_LAS bf16x8*)(lds + PG8_SB(b, h) + boff + n * 2048 + k * 1024); } while (0)
#define PG8_MMA(ai, bj, At, Bt) do { __builtin_amdgcn_s_setprio(1); _Pragma("unroll") for (int m = 0; m < 4; ++m) _Pragma("unroll") for (int n = 0; n < 2; ++n) _Pragma("unroll") for (int k = 0; k < 2; ++k) \
        acc[ai][bj][m][n] = __builtin_amdgcn_mfma_f32_16x16x32_bf16(Bt[n][k], At[m][k], acc[ai][bj][m][n], 0, 0, 0); __builtin_amdgcn_s_setprio(0); } while (0)
#define PG8_WAIT_V(n) asm volatile("s_waitcnt vmcnt(" #n ")" ::: "memory")
#define PG8_WAIT_L(n) asm volatile("s_waitcnt lgkmcnt(" #n ")" ::: "memory")
#define PG8_BAR __builtin_amdgcn_s_barrier()
#define PG8_SCHED __builtin_amdgcn_sched_barrier(0)
    Unit cur, nxt; int ui = 0;
    if (!S.next(0, cur)) return;
    f32x4 acc[2][2][4][2];
#pragma unroll
    for (int a = 0; a < 2; ++a)
#pragma unroll
        for (int b = 0; b < 2; ++b)
#pragma unroll
            for (int m = 0; m < 4; ++m)
#pragma unroll
                for (int n = 0; n < 2; ++n) acc[a][b][m][n] = (f32x4){0.f, 0.f, 0.f, 0.f};
    bf16x8 At[4][2], B0[2][2], B1[2][2];
    const char* cA = (const char*)g.A + (size_t)cur.pm * tstep; const char* cB = (const char*)g.Bt + (size_t)cur.pn * tstep;
    S.a_ready(cur);
    if constexpr (SP2) {
        PG8_STAGE(PG8_SB(0, 0), cB, voffB); PG8_STAGE(PG8_SB(0, 1), cB + hstep, voffB); PG8_STAGE(PG8_SA(0, 0), cA, voffA); PG8_STAGE(PG8_SA(0, 1), cA + hstep, voffA);
        if (wr == 1) PG8_BAR;
        PG8_WAIT_V(2); PG8_BAR;
        PG8_STAGE(PG8_SB(1, 0), cB + kstep, voffB); PG8_STAGE(PG8_SA(1, 0), cA + kstep, voffA); PG8_STAGE(PG8_SB(1, 1), cB + hstep + kstep, voffB);
        PG8_WAIT_V(6); PG8_BAR;
    } else {
        PG8_STAGE(PG8_SB(0, 0), cB, voffB); PG8_STAGE(PG8_SA(0, 0), cA, voffA); PG8_STAGE(PG8_SB(0, 1), cB + hstep, voffB); PG8_STAGE(PG8_SA(0, 1), cA + hstep, voffA);
        if (wr == 1) PG8_BAR;
        PG8_WAIT_V(4); PG8_BAR;
        PG8_STAGE(PG8_SB(1, 0), cB + kstep, voffB); PG8_STAGE(PG8_SA(1, 0), cA + kstep, voffA); PG8_STAGE(PG8_SB(1, 1), cB + hstep + kstep, voffB);
        PG8_WAIT_V(6); PG8_BAR;
    }
    for (;;) {
        const bool has_next = S.next(ui + 1, nxt);
        const char* nA = has_next ? (const char*)g.A + (size_t)nxt.pm * tstep : cA; const char* nB = has_next ? (const char*)g.Bt + (size_t)nxt.pn * tstep : cB;
        for (int t = 0; t < nt; t += 2) {
            const bool last = (t == nt - 2);
            const char* a1 = cA + (size_t)(t + 1) * kstep;
            const char* a2 = last ? nA : cA + (size_t)(t + 2) * kstep; const char* b2 = last ? nB : cB + (size_t)(t + 2) * kstep;
            const char* a3 = a2 + kstep; const char* b3 = b2 + kstep;
            if (last && has_next) S.a_ready(nxt);
            if constexpr (SP2) {
            PG8_LDB(B0, 0, 0); PG8_LDB(B1, 0, 1); PG8_SCHED; PG8_LDA(At, 0, 0); PG8_STAGE(PG8_SA(1, 1), a1 + hstep, voffA);
            PG8_WAIT_V(8); PG8_WAIT_L(0); PG8_BAR; PG8_MMA(0, 0, At, B0); PG8_MMA(0, 1, At, B1); PG8_BAR; PG8_SCHED;
            PG8_LDA(At, 0, 1); PG8_STAGE(PG8_SB(0, 0), b2, voffB); PG8_STAGE(PG8_SB(0, 1), b2 + hstep, voffB); PG8_STAGE(PG8_SA(0, 0), a2, voffA);
            PG8_WAIT_V(8); PG8_WAIT_L(0); PG8_BAR; PG8_MMA(1, 0, At, B0); PG8_MMA(1, 1, At, B1); PG8_BAR; PG8_SCHED;
            PG8_LDB(B0, 1, 0); PG8_LDB(B1, 1, 1); PG8_SCHED; PG8_LDA(At, 1, 0); PG8_STAGE(PG8_SA(0, 1), a2 + hstep, voffA);
            PG8_WAIT_V(8); PG8_WAIT_L(0); PG8_BAR; PG8_MMA(0, 0, At, B0); PG8_MMA(0, 1, At, B1); PG8_BAR; PG8_SCHED;
            PG8_LDA(At, 1, 1); PG8_STAGE(PG8_SB(1, 0), b3, voffB); PG8_STAGE(PG8_SB(1, 1), b3 + hstep, voffB); PG8_STAGE(PG8_SA(1, 0), a3, voffA);
            PG8_WAIT_V(8); PG8_WAIT_L(0); PG8_BAR; PG8_MMA(1, 0, At, B0); PG8_MMA(1, 1, At, B1); PG8_BAR; PG8_SCHED;
            } else {
            PG8_LDB(B0, 0, 0); PG8_SCHED; PG8_LDA(At, 0, 0); PG8_STAGE(PG8_SA(1, 1), a1 + hstep, voffA);
            PG8_WAIT_L(8); PG8_BAR; PG8_WAIT_L(0); PG8_MMA(0, 0, At, B0); PG8_BAR; PG8_SCHED;
            PG8_LDB(B1, 0, 1); PG8_STAGE(PG8_SB(0, 0), b2, voffB);
            PG8_BAR; PG8_WAIT_L(0); PG8_MMA(0, 1, At, B1); PG8_BAR;
            PG8_LDA(At, 0, 1); PG8_STAGE(PG8_SA(0, 0), a2, voffA);
            PG8_BAR; PG8_WAIT_L(0); PG8_MMA(1, 0, At, B0); PG8_BAR; PG8_SCHED;
            PG8_STAGE(PG8_SB(0, 1), b2 + hstep, voffB);
            PG8_WAIT_V(6); PG8_BAR; PG8_MMA(1, 1, At, B1); PG8_BAR;
            PG8_LDB(B0, 1, 0); PG8_SCHED; PG8_LDA(At, 1, 0); PG8_STAGE(PG8_SA(0, 1), a2 + hstep, voffA);
            PG8_WAIT_L(8); PG8_BAR; PG8_WAIT_L(0); PG8_MMA(0, 0, At, B0); PG8_BAR; PG8_SCHED;
            PG8_LDB(B1, 1, 1); PG8_STAGE(PG8_SB(1, 0), b3, voffB);
            PG8_BAR; PG8_WAIT_L(0); PG8_MMA(0, 1, At, B1); PG8_BAR;
            PG8_LDA(At, 1, 1); PG8_STAGE(PG8_SA(1, 0), a3, voffA);
            PG8_BAR; PG8_WAIT_L(0); PG8_MMA(1, 0, At, B0); PG8_BAR; PG8_SCHED;
            PG8_STAGE(PG8_SB(1, 1), b3 + hstep, voffB);
            PG8_WAIT_V(6); PG8_BAR; PG8_MMA(1, 1, At, B1); PG8_BAR;
            }
        }
        if constexpr (ALIGN_EPI) { if (wr == 0) PG8_BAR; }
        if constexpr (!Epi::AFTER_DRAIN) { E(acc, cur, wr, wc, fr, fq); S.done(cur); }
        if (!has_next) break;
#pragma unroll
        for (int a = 0; a < 2; ++a)
#pragma unroll
            for (int b = 0; b < 2; ++b)
#pragma unroll
                for (int m = 0; m < 4; ++m)
#pragma unroll
                    for (int n = 0; n < 2; ++n) acc[a][b][m][n] = (f32x4){0.f, 0.f, 0.f, 0.f};
        cur = nxt; cA = nA; cB = nB; ++ui;
        if constexpr (ALIGN_EPI) { if (wr == 1) PG8_BAR; }
    }
    PG8_WAIT_V(0);
    if constexpr (!ALIGN_EPI) { if (wr == 0) PG8_BAR; }
    PG8_BAR;
    if constexpr (Epi::AFTER_DRAIN) { E.fused(acc, cur, wr, wc, fr, fq, lds, wid, lane); S.done(cur); }
#undef PG8_SA
#undef PG8_SB
#undef PG8_STAGE
#undef PG8_LDA
#undef PG8_LDB
#undef PG8_MMA
#undef PG8_WAIT_V
#undef PG8_WAIT_L
#undef PG8_BAR
#undef PG8_SCHED
}
}

#define XB_TMO      128
#define XB_XCNT(j)  (256  + 64 * (j))
#define XB_XSUB(j)  (1280 + 64 * (j))
#define XB_XGEN(j)  (2304 + 64 * (j))
#define XB_TOP      3328
#define XB_TOPGEN   3392
#define XCD_BAR_WORDS 3456
#define XB_SPIN_CAP (1u << 18)

__device__ __forceinline__ unsigned xb_ld(unsigned* p)              { return __hip_atomic_load(p, __ATOMIC_RELAXED, __HIP_MEMORY_SCOPE_AGENT); }
__device__ __forceinline__ unsigned xb_add(unsigned* p, unsigned v) { return __hip_atomic_fetch_add(p, v, __ATOMIC_RELAXED, __HIP_MEMORY_SCOPE_AGENT); }
__device__ __forceinline__ unsigned xb_xcc_id() { return (unsigned)__builtin_amdgcn_s_getreg((3 << 11) | 20) & 0xFu; }
#define XB_SPIN(cond, bar) do { unsigned _sp = 0; while (cond) { __builtin_amdgcn_s_sleep(1); \
    if ((++_sp & 255u) == 0u) { if (xb_ld(&(bar)[XB_TMO])) break; if (_sp > XB_SPIN_CAP) { atomicAdd(&(bar)[XB_TMO], 1u); break; } } } } while (0)

struct XcdBarrier {
    unsigned* bar; unsigned x;
    volatile LAS unsigned* st;
};

__device__ __forceinline__ XcdBarrier xcd_barrier_post(unsigned* bar, volatile LAS unsigned* st) {
    XcdBarrier b; b.bar = bar; b.x = xb_xcc_id(); b.st = st;
    if (threadIdx.x == 0) (void)xb_add(&bar[XB_XCNT(b.x)], 1u);
    return b;
}
__device__ __forceinline__ void xcd_barrier_complete(unsigned* bar, unsigned x, unsigned& nloc, unsigned& nx) {
    const unsigned G = gridDim.x * gridDim.y * gridDim.z;
    unsigned sum, cnt, mine, sp = 0u;
    for (;;) {
        sum = 0u; cnt = 0u; mine = 0u;
#pragma unroll
        for (unsigned j = 0; j < 16; ++j) { const unsigned c = xb_ld(&bar[XB_XCNT(j)]); sum += c; cnt += (c > 0u) ? 1u : 0u; mine = (j == x) ? c : mine; }
        if (sum == G) break;
        __builtin_amdgcn_s_sleep(1);
        if ((++sp & 255u) == 0u) { if (xb_ld(&bar[XB_TMO])) break; if (sp > XB_SPIN_CAP) { atomicAdd(&bar[XB_TMO], 1u); break; } }
    }
    nloc = mine > 0u ? mine : 1u; nx = cnt > 0u ? cnt : 1u;
}

__device__ __forceinline__ void xcd_barrier(const XcdBarrier& b) {
    asm volatile("s_waitcnt vmcnt(0)" ::: "memory");
    __syncthreads();
    if (threadIdx.x == 0) {
        unsigned* bar = b.bar;
        __builtin_amdgcn_s_waitcnt(0);
        unsigned nloc = b.st[0], nx = b.st[1];
        if (nloc == 0u) { xcd_barrier_complete(bar, b.x, nloc, nx); b.st[0] = nloc; b.st[1] = nx; }
        const unsigned old = xb_add(&bar[XB_XSUB(b.x)], 1u);
        const unsigned gen = old / nloc;
        if (old + 1u == (gen + 1u) * nloc) {
            __builtin_amdgcn_fence(__ATOMIC_RELEASE, "agent");
            asm volatile("s_waitcnt vmcnt(0)" ::: "memory");
            const unsigned og = xb_add(&bar[XB_TOP], 1u);
            const unsigned tg = og / nx;
            if (og + 1u == (tg + 1u) * nx) xb_add(&bar[XB_TOPGEN], 1u);
            else XB_SPIN(xb_ld(&bar[XB_TOPGEN]) == tg, bar);
            __builtin_amdgcn_fence(__ATOMIC_ACQUIRE, "agent");
            xb_add(&bar[XB_XGEN(b.x)], 1u);
            asm volatile("s_waitcnt vmcnt(0)" ::: "memory");
        } else {
            XB_SPIN(xb_ld(&bar[XB_XGEN(b.x)]) == gen, bar);
            __builtin_amdgcn_fence(__ATOMIC_ACQUIRE, "agent");
            asm volatile("s_waitcnt vmcnt(0)" ::: "memory");
        }
    }
    __syncthreads();
}

constexpr int DM = 4096, NBATCH = 4, SEQ = 4096, MTOK = NBATCH * SEQ;
constexpr int AH = 8, ADV = 512, ADK = 256, AQKW = 2048;
constexpr int BH = 32, BHD = 128;
constexpr int L0COLS = 32800;
constexpr int CWID = 8192, CGR = 8, CCH = 128, CGC = 1024;
constexpr int NCHUNK = SEQ / 128;
constexpr float EPS = 1e-6f;
constexpr int C_AQ = 0, C_AK = 2048, C_AV = 4096, C_AO = 8192, C_AZ = 12288, C_GT = 16384, C_BQ = 16416, C_BK = 20512, C_BV = 24608, C_BZ = 28704;

#ifndef MK_N_LAUNCHES
#define MK_N_LAUNCHES 1
#endif
constexpr int NPHASE = 12;
constexpr int N_LAUNCHES = MK_N_LAUNCHES;

constexpr size_t MiB = 1u << 20;
constexpr size_t WS_CTL = 0, CTL_ZERO_BYTES = 1 * MiB;
constexpr int CW_BAR = 1024;
constexpr int CW_QUEUE = 8192;
constexpr size_t WS_MOD = 64 * 1024;
constexpr size_t WS_WG = 1 * MiB;
constexpr size_t WS_GATES = 2 * MiB;
constexpr size_t WS_R1 = 4 * MiB, WS_R2 = 5 * MiB;
constexpr size_t WS_DEC = 6 * MiB;
constexpr size_t WS_NST = 7 * MiB;
constexpr size_t WS_VSS = 10 * MiB;
constexpr size_t WS_W0A = 16 * MiB;
constexpr size_t WS_W0V = 208 * MiB;
constexpr size_t WS_H = 272 * MiB;
constexpr size_t WS_QKRAW = 400 * MiB;
constexpr size_t WS_CT = 16 * MiB;
constexpr size_t WS_WOUT0 = 528 * MiB;
constexpr size_t WS_GA = 592 * MiB;
constexpr size_t WS_BQK = 720 * MiB;
constexpr size_t WS_BZ = 976 * MiB;
constexpr size_t WS_VT = 1104 * MiB;
constexpr size_t WS_QC = 1360 * MiB;
constexpr size_t WS_KAF = 1424 * MiB, WS_KAB = 1488 * MiB;
constexpr size_t WS_KAFT = 1552 * MiB, WS_KABT = 1616 * MiB;
constexpr size_t WS_YCAT = 1680 * MiB;
constexpr size_t WS_END0 = 1936 * MiB;
constexpr size_t WS_W1A = 16 * MiB;
constexpr size_t WS_W1V = 144 * MiB;
constexpr size_t WS_WOUT1 = 208 * MiB;
constexpr size_t WS_UZ = 592 * MiB;
constexpr size_t WS_GVT = 848 * MiB;
constexpr size_t WS_Y1 = 1104 * MiB;
constexpr size_t WS_X1 = 1360 * MiB;
constexpr size_t WS_NEED = WS_END0;

constexpr int RING_BYTES = 131072;
constexpr int MISC_OFF = 147456 - 256;
constexpr int LDS_BYTES = 147456;
constexpr int NWAVES = 8, NTHREADS = 512;

#define GAS __attribute__((address_space(1)))
typedef unsigned short bf16;
typedef unsigned v4u __attribute__((ext_vector_type(4)));
typedef unsigned v2u __attribute__((ext_vector_type(2)));
typedef float f32x4 __attribute__((ext_vector_type(4)));
#define LDS_WAIT() asm volatile("s_waitcnt lgkmcnt(0)" ::: "memory")
__device__ __forceinline__ float bf2f(unsigned short b) { return __uint_as_float(((unsigned)b) << 16); }
__device__ __forceinline__ unsigned f2bf(float f) { unsigned u = __float_as_uint(f); return (u + 0x7fffu + ((u >> 16) & 1u)) >> 16; }
__device__ __forceinline__ unsigned pk2(float lo, float hi) { unsigned r; asm("v_cvt_pk_bf16_f32 %0, %1, %2" : "=v"(r) : "v"(lo), "v"(hi)); return r; }
__device__ __forceinline__ float lo16(unsigned w) { return __uint_as_float(w << 16); }
__device__ __forceinline__ float hi16(unsigned w) { return __uint_as_float(w & 0xffff0000u); }
__device__ __forceinline__ float siluf_(float x) { return x * __builtin_amdgcn_rcpf(1.0f + __builtin_amdgcn_exp2f(-1.4426950408889634f * x)); }
__device__ __forceinline__ float logsigf_(float x) { return fminf(x, 0.f) - log1pf(__expf(-fabsf(x))); }
__device__ __forceinline__ float wave_sum(float v) {
#pragma unroll
    for (int o = 1; o < 64; o <<= 1) v += __shfl_xor(v, o);
    return v;
}

struct Args {
    const float* in[21]; float* out; unsigned char* ws; int ph_lo, ph_hi;
};
struct Frame { LAS unsigned char* lds; int tid, lane, wave, G, bid; };

__device__ __forceinline__ void transpose_item(const float* W, int ldw, int K, bf16* WT, int dst_row0, int src_col0, int kb, LAS float* scr, int lane) {
    const int k0 = 64 * kb;
    float tv[32];
    const float* wp = W + (size_t)(k0 + (lane >> 5)) * ldw + src_col0 + (lane & 31);
#pragma unroll
    for (int i = 0; i < 32; ++i) tv[i] = __builtin_nontemporal_load(wp + (size_t)(2 * i) * ldw);
#pragma unroll
    for (int i = 0; i < 32; ++i) scr[(2 * i + (lane >> 5)) * 33 + (lane & 31)] = tv[i];
    LDS_WAIT(); asm volatile("" ::: "memory");
    const int c = lane & 7;
#pragma unroll
    for (int j = 0; j < 4; ++j) { const int n = (lane >> 3) + 8 * j; const LAS float* s = scr + (8 * c) * 33 + n;
        v4u o; o.x = pk2(s[0 * 33], s[1 * 33]); o.y = pk2(s[2 * 33], s[3 * 33]); o.z = pk2(s[4 * 33], s[5 * 33]); o.w = pk2(s[6 * 33], s[7 * 33]);
        *(v4u*)(WT + (size_t)(dst_row0 + n) * K + k0 + 8 * c) = o; }
    LDS_WAIT(); asm volatile("" ::: "memory");
}
__device__ __forceinline__ int map_w0a(int n) {
    if (n < 4096) return n;
    if (n < 12288) { const int t = (n - 4096) >> 8, w = (n - 4096) & 255; return (w < 128 ? C_AO : C_AZ) + 128 * t + (w & 127); }
    if (n < 20480) return C_BQ + (n - 12288);
    return C_BZ + (n - 20480);
}
__device__ __forceinline__ int map_w1a(int n) {
    const int t = n >> 8, w = n & 255; return (w < 128 ? 0 : 16384) + 128 * t + (w & 127);
}
__device__ __forceinline__ void ada_items(const Args& A, Frame& F, int dummy) {
    LAS float* sc = (LAS float*)(F.lds);
    for (int it = F.bid; it < 2 * 64 * 6; it += F.G) {
        const int layer = it / 384, r = it % 384, kb = r / 6, cg = r % 6, k0 = kb * 64;
        const float* w = layer ? A.in[14] : A.in[3];
        float* mod = (float*)(A.ws + WS_MOD) + (size_t)(layer + 2 * dummy) * 4 * 12288;
        __syncthreads();
        if (F.tid < 256) { const int b = F.tid >> 6, kk = F.tid & 63; sc[b * 64 + kk] = siluf_(A.in[1][b * DM + k0 + kk]); }
        __syncthreads();
        const int j0 = cg * 2048 + 4 * F.tid;
        f32x4 a0 = {0.f, 0.f, 0.f, 0.f}, a1 = a0, a2 = a0, a3 = a0;
#pragma unroll 8
        for (int kk = 0; kk < 64; ++kk) { const f32x4 wv = __builtin_nontemporal_load((const f32x4*)(w + (size_t)(k0 + kk) * 12288 + j0));
            a0 += wv * sc[kk]; a1 += wv * sc[64 + kk]; a2 += wv * sc[128 + kk]; a3 += wv * sc[192 + kk]; }
#pragma unroll
        for (int i = 0; i < 4; ++i) { atomicAdd(mod + 0 * 12288 + j0 + i, a0[i]); atomicAdd(mod + 1 * 12288 + j0 + i, a1[i]); atomicAdd(mod + 2 * 12288 + j0 + i, a2[i]); atomicAdd(mod + 3 * 12288 + j0 + i, a3[i]); }
    }
    __syncthreads();
}
__device__ __forceinline__ void p0_prep(const Args& A, Frame& F) {
    LAS float* scr = (LAS float*)(F.lds + 4096 + F.wave * 8704);
    const int gw = F.bid * NWAVES + F.wave, NGW = F.G * NWAVES;
    bf16* W0A = (bf16*)(A.ws + WS_W0A); bf16* W0V = (bf16*)(A.ws + WS_W0V); bf16* WO0 = (bf16*)(A.ws + WS_WOUT0);
    constexpr int I_A = 64 * 768, I_V = 64 * 256, I_O = 128 * 128, I_G = 64;
    for (int it = gw; it < I_A + I_V + I_O + I_G; it += NGW) {
        int r = it;
        if (r < I_G) { transpose_item(A.in[5], L0COLS, DM, (bf16*)(A.ws + WS_WG), 0, C_GT, r, scr, F.lane); continue; } r -= I_G;
        if (r < I_A) { const int kb = r / 768, db = r % 768; transpose_item(A.in[5], L0COLS, DM, W0A, 32 * db, map_w0a(32 * db), kb, scr, F.lane); continue; } r -= I_A;
        if (r < I_V) { const int kb = r / 256, db = r % 256, n = 32 * db; transpose_item(A.in[5], L0COLS, DM, W0V, n, n < 4096 ? C_AV + n : C_BV + (n - 4096), kb, scr, F.lane); continue; } r -= I_V;
        { const int kb = r / 128, db = r % 128; transpose_item(A.in[12], DM, 8192, WO0, 32 * db, 32 * db, kb, scr, F.lane); }
    }
}
__device__ __forceinline__ void p7_prep1(const Args& A, Frame& F) {
    LAS float* scr = (LAS float*)(F.lds + 4096 + F.wave * 8704);
    const int gw = F.bid * NWAVES + F.wave, NGW = F.G * NWAVES;
    bf16* W1A = (bf16*)(A.ws + WS_W1A); bf16* W1V = (bf16*)(A.ws + WS_W1V); bf16* WO1 = (bf16*)(A.ws + WS_WOUT1);
    constexpr int I_A = 64 * 512, I_V = 64 * 256, I_O = 128 * 128;
    for (int it = gw; it < I_A + I_V + I_O; it += NGW) {
        int r = it;
        if (r < I_A) { const int kb = r / 512, db = r % 512; transpose_item(A.in[16], 3 * CWID, DM, W1A, 32 * db, map_w1a(32 * db), kb, scr, F.lane); continue; } r -= I_A;
        if (r < I_V) { const int kb = r / 256, db = r % 256; transpose_item(A.in[16], 3 * CWID, DM, W1V, 32 * db, 8192 + 32 * db, kb, scr, F.lane); continue; } r -= I_V;
        { const int kb = r / 128, db = r % 128; transpose_item(A.in[20], DM, 8192, WO1, 32 * db, 32 * db, kb, scr, F.lane); }
    }
}
template <bool IN_BF16> __device__ __forceinline__ void norm_rows(const Args& A, Frame& F, const void* xin, const float* g, const float* mod, const float* adab, bf16* H) {
    LAS float* PA = (LAS float*)F.lds; LAS float* PS = PA + NBATCH * DM;
    __syncthreads();
    for (int e = F.tid; e < NBATCH * DM; e += NTHREADS) { const int b = e >> 12, c = e & (DM - 1);
        PA[e] = g[c] * (1.0f + mod[(size_t)b * 12288 + DM + c] + adab[DM + c]); PS[e] = mod[(size_t)b * 12288 + c] + adab[c]; }
    __syncthreads();
    const int gw = F.bid * NWAVES + F.wave, NGW = F.G * NWAVES;
    typedef typename std::conditional<IN_BF16, v4u, f32x4>::type xv_t;
    constexpr int NV = IN_BF16 ? 8 : 16;
    xv_t xa[NV], xb[NV];
#define NR_LOAD(X_, m_) do { if ((m_) < MTOK) { _Pragma("unroll") for (int j = 0; j < 8; ++j) { \
            if (IN_BF16) X_[j] = *(const xv_t*)((const bf16*)xin + (size_t)(m_) * DM + 512 * j + 8 * F.lane); \
            else { X_[2 * j] = *(const xv_t*)((const float*)xin + (size_t)(m_) * DM + 512 * j + 8 * F.lane); X_[2 * j + 1] = *(const xv_t*)((const float*)xin + (size_t)(m_) * DM + 512 * j + 8 * F.lane + 4); } } } } while (0)
#define NR_PROC(X_, m_) do { if ((m_) < MTOK) { float v[8][8]; float s = 0.f; \
            _Pragma("unroll") for (int j = 0; j < 8; ++j) { \
                if (IN_BF16) { const v4u w = __builtin_bit_cast(v4u, X_[j]); v[j][0] = lo16(w.x); v[j][1] = hi16(w.x); v[j][2] = lo16(w.y); v[j][3] = hi16(w.y); v[j][4] = lo16(w.z); v[j][5] = hi16(w.z); v[j][6] = lo16(w.w); v[j][7] = hi16(w.w); } \
                else { const f32x4 p0 = __builtin_bit_cast(f32x4, X_[IN_BF16 ? j : 2 * j]), p1 = __builtin_bit_cast(f32x4, X_[IN_BF16 ? j : 2 * j + 1]); v[j][0] = p0[0]; v[j][1] = p0[1]; v[j][2] = p0[2]; v[j][3] = p0[3]; v[j][4] = p1[0]; v[j][5] = p1[1]; v[j][6] = p1[2]; v[j][7] = p1[3]; } \
                s += ((v[j][0] * v[j][0] + v[j][1] * v[j][1]) + (v[j][2] * v[j][2] + v[j][3] * v[j][3])) + ((v[j][4] * v[j][4] + v[j][5] * v[j][5]) + (v[j][6] * v[j][6] + v[j][7] * v[j][7])); } \
            const float rstd = rsqrtf(wave_sum(s) * (1.f / DM) + EPS); const int pb = ((m_) / SEQ) * DM + 8 * F.lane; \
            _Pragma("unroll") for (int j = 0; j < 8; ++j) { const f32x4 a0 = *(const LAS f32x4*)(PA + pb + 512 * j), a1 = *(const LAS f32x4*)(PA + pb + 512 * j + 4), s0 = *(const LAS f32x4*)(PS + pb + 512 * j), s1 = *(const LAS f32x4*)(PS + pb + 512 * j + 4); \
                v4u o; o.x = pk2(v[j][0] * rstd * a0[0] + s0[0], v[j][1] * rstd * a0[1] + s0[1]); o.y = pk2(v[j][2] * rstd * a0[2] + s0[2], v[j][3] * rstd * a0[3] + s0[3]); \
                o.z = pk2(v[j][4] * rstd * a1[0] + s1[0], v[j][5] * rstd * a1[1] + s1[1]); o.w = pk2(v[j][6] * rstd * a1[2] + s1[2], v[j][7] * rstd * a1[3] + s1[3]); \
                *(v4u*)(H + (size_t)(m_) * DM + 512 * j + 8 * F.lane) = o; } } } while (0)
    NR_LOAD(xa, gw);
#pragma unroll 1
    for (int m = gw; m < MTOK; m += 2 * NGW) {
        NR_LOAD(xb, m + NGW); __builtin_amdgcn_sched_barrier(0);
        NR_PROC(xa, m); __builtin_amdgcn_sched_barrier(0);
        NR_LOAD(xa, m + 2 * NGW); __builtin_amdgcn_sched_barrier(0);
        NR_PROC(xb, m + NGW); __builtin_amdgcn_sched_barrier(0);
    }
#undef NR_LOAD
#undef NR_PROC
    __syncthreads();
}


typedef short bf16x8 __attribute__((ext_vector_type(8)));
#define MFMA16(a, b, c) __builtin_amdgcn_mfma_f32_16x16x32_bf16((a), (b), (c), 0, 0, 0)
__device__ __forceinline__ void gates_mfma(const Args& A, Frame& F) {
    const bf16* H = (const bf16*)(A.ws + WS_H); const bf16* WG = (const bf16*)(A.ws + WS_WG); float* GT = (float*)(A.ws + WS_GATES);
    const int fr = F.lane & 15, fq = F.lane >> 4, mt = F.wave >> 1, nt = F.wave & 1;
    for (int rb = F.bid; rb < MTOK / 64; rb += F.G) {
        const bf16* ap = H + (size_t)(rb * 64 + mt * 16 + fr) * DM + 8 * fq; const bf16* bp = WG + (size_t)(nt * 16 + fr) * DM + 8 * fq;
        f32x4 acc = {0.f, 0.f, 0.f, 0.f};
#pragma unroll 16
        for (int ks = 0; ks < DM / 32; ++ks) { const bf16x8 a = *(const bf16x8*)(ap + 32 * ks), b = *(const bf16x8*)(bp + 32 * ks); acc = MFMA16(a, b, acc); }
        const float bias = A.in[7][nt * 16 + fr];
#pragma unroll
        for (int i = 0; i < 4; ++i) GT[(size_t)(rb * 64 + mt * 16 + 4 * fq + i) * 32 + nt * 16 + fr] = acc[i] + bias;
    }
}


__device__ __forceinline__ float wave_incl_scan(float x, int lane) {
#pragma unroll
    for (int o = 1; o < 64; o <<= 1) { const float y = __shfl_up(x, o); if (lane >= o) x += y; }
    return x;
}
__device__ __forceinline__ void mid_opt(const Args& A, Frame& F) {
    const float* GT = (const float*)(A.ws + WS_GATES);
    float* R1 = (float*)(A.ws + WS_R1); float* R2 = (float*)(A.ws + WS_R2); float* DEC = (float*)(A.ws + WS_DEC);
    const bf16* QKR = (const bf16*)(A.ws + WS_QKRAW);
    bf16* QC = (bf16*)(A.ws + WS_QC); bf16* KAF = (bf16*)(A.ws + WS_KAF); bf16* KAB = (bf16*)(A.ws + WS_KAB); bf16* KAFT = (bf16*)(A.ws + WS_KAFT); bf16* KABT = (bf16*)(A.ws + WS_KABT);
    LAS unsigned short* Tf = (LAS unsigned short*)F.lds;
    LAS unsigned short* Tb = (LAS unsigned short*)(F.lds + 69632);
    LAS float* L = (LAS float*)(F.lds + 139264);
    LAS float *af = L, *ab = L + 128, *wt = L + 256;
    LAS float* cwl = L + 264;
    const float* cw = A.in[6];
    for (int it = F.bid; it < NBATCH * AH * NCHUNK; it += F.G) {
        const int b = it >> 8, h = (it >> 5) & 7, j = it & 31; const int m0 = b * SEQ + j * 128;
            const int s_lo = F.tid >> 5, c8 = (F.tid & 31) * 8; const int cq = h * 256 + c8, ck = 2048 + h * 256 + c8;
            v4u qA[2][3], kA[2][3], qB[2][3], kB[2][3];
#define MO_LOAD(Q_, K_, p0_) do { int sl_ = s_lo; asm volatile("" : "+v"(sl_)); _Pragma("unroll") for (int pp = 0; pp < 2; ++pp) { const int s = ((p0_) + pp) * 16 + sl_, tok = j * 128 + s; const size_t row = (size_t)(m0 + s); const v4u z4 = {0u, 0u, 0u, 0u}; \
                Q_[pp][0] = tok > 0 ? *(const v4u*)(QKR + (row - 1) * DM + cq) : z4; Q_[pp][1] = *(const v4u*)(QKR + row * DM + cq); Q_[pp][2] = tok < SEQ - 1 ? *(const v4u*)(QKR + (row + 1) * DM + cq) : z4; \
                K_[pp][0] = tok > 0 ? *(const v4u*)(QKR + (row - 1) * DM + ck) : z4; K_[pp][1] = *(const v4u*)(QKR + row * DM + ck); K_[pp][2] = tok < SEQ - 1 ? *(const v4u*)(QKR + (row + 1) * DM + ck) : z4; } } while (0)
            MO_LOAD(qA, kA, 0); MO_LOAD(qB, kB, 2);
        float cwv[3];
#pragma unroll
        for (int k = 0; k < 3; ++k) { const int c = F.tid; cwv[k] = cw[k * DM + (c < 256 ? h * 256 + c : 2048 + h * 256 + (c - 256))]; }
        float g_if = 0.f, g_ff = 0.f, g_ib = 0.f, g_fb = 0.f;
        if (F.tid < 128) { const float* gr = GT + (size_t)(m0 + F.tid) * 32; g_if = gr[h]; g_ff = gr[8 + h]; g_ib = gr[16 + h]; g_fb = gr[24 + h]; }
        __builtin_amdgcn_sched_barrier(0);
        __syncthreads();
#pragma unroll
        for (int k = 0; k < 3; ++k) cwl[k * 512 + F.tid] = cwv[k];
        float igf = 0.f, igb = 0.f, lff = 0.f, lfb = 0.f, pf = 0.f, pb = 0.f;
        if (F.tid < 128) {
            igf = g_if; lff = logsigf_(g_ff); igb = g_ib; lfb = logsigf_(g_fb);
            pf = wave_incl_scan(lff, F.lane); pb = wave_incl_scan(lfb, F.lane);
            if (F.tid == 63) { wt[0] = pf; wt[1] = pb; } }
        __syncthreads();
        if (F.tid < 128) { if (F.tid >= 64) { pf += wt[0]; pb += wt[1]; } if (F.tid == 127) { wt[2] = pf; wt[3] = pb; } }
        __syncthreads();
        if (F.tid < 128) { const int s = F.tid; const float gLf = wt[2], gLb = wt[3];
            const float gf = pf, gb = gLb - pb + lfb;
            af[s] = __expf(igf + gLf - gf); ab[s] = __expf(igb + gLb - gb);
            const size_t o = (size_t)(b * AH + h) * SEQ + j * 128 + s, od = (size_t)NBATCH * AH * SEQ;
            R1[o] = __expf(gf); R2[o] = __expf(gf - gLf); R1[od + o] = __expf(gb); R2[od + o] = __expf(gb - gLb);
            if (s == 0) { DEC[(b * AH + h) * NCHUNK + j] = __expf(gLf); DEC[NBATCH * AH * NCHUNK + (b * AH + h) * NCHUNK + j] = __expf(gLb); } }
        __syncthreads();
        {
#define MO_PROC(Q_, K_, p0_) do { int sl_ = s_lo; asm volatile("" : "+v"(sl_)); _Pragma("unroll") for (int pp = 0; pp < 2; ++pp) { const int s = ((p0_) + pp) * 16 + sl_; const size_t row = (size_t)(m0 + s); \
                const unsigned qa[4] = {Q_[pp][0].x, Q_[pp][0].y, Q_[pp][0].z, Q_[pp][0].w}, qb[4] = {Q_[pp][1].x, Q_[pp][1].y, Q_[pp][1].z, Q_[pp][1].w}, qd[4] = {Q_[pp][2].x, Q_[pp][2].y, Q_[pp][2].z, Q_[pp][2].w}; \
                const unsigned ka[4] = {K_[pp][0].x, K_[pp][0].y, K_[pp][0].z, K_[pp][0].w}, kb[4] = {K_[pp][1].x, K_[pp][1].y, K_[pp][1].z, K_[pp][1].w}, kd[4] = {K_[pp][2].x, K_[pp][2].y, K_[pp][2].z, K_[pp][2].w}; \
                float qv[8], kv[8]; \
                _Pragma("unroll") for (int i = 0; i < 4; ++i) { \
                    const f32x4 t0 = *(const LAS f32x4*)(cwl + c8 + 4 * (i >> 1)), t1 = *(const LAS f32x4*)(cwl + 512 + c8 + 4 * (i >> 1)), t2 = *(const LAS f32x4*)(cwl + 1024 + c8 + 4 * (i >> 1)); \
                    const f32x4 u0 = *(const LAS f32x4*)(cwl + 256 + c8 + 4 * (i >> 1)), u1 = *(const LAS f32x4*)(cwl + 768 + c8 + 4 * (i >> 1)), u2 = *(const LAS f32x4*)(cwl + 1280 + c8 + 4 * (i >> 1)); \
                    const int e0 = 2 * (i & 1); \
                    qv[2 * i] = siluf_(t0[e0] * lo16(qa[i]) + t1[e0] * lo16(qb[i]) + t2[e0] * lo16(qd[i])) * 0.0625f; \
                    qv[2 * i + 1] = siluf_(t0[e0 + 1] * hi16(qa[i]) + t1[e0 + 1] * hi16(qb[i]) + t2[e0 + 1] * hi16(qd[i])) * 0.0625f; \
                    kv[2 * i] = siluf_(u0[e0] * lo16(ka[i]) + u1[e0] * lo16(kb[i]) + u2[e0] * lo16(kd[i])); \
                    kv[2 * i + 1] = siluf_(u0[e0 + 1] * hi16(ka[i]) + u1[e0 + 1] * hi16(kb[i]) + u2[e0 + 1] * hi16(kd[i])); } \
                const float fa = af[s], fb = ab[s]; \
                v4u oq, of, ob; \
                oq.x = pk2(qv[0], qv[1]); oq.y = pk2(qv[2], qv[3]); oq.z = pk2(qv[4], qv[5]); oq.w = pk2(qv[6], qv[7]); \
                of.x = pk2(kv[0] * fa, kv[1] * fa); of.y = pk2(kv[2] * fa, kv[3] * fa); of.z = pk2(kv[4] * fa, kv[5] * fa); of.w = pk2(kv[6] * fa, kv[7] * fa); \
                ob.x = pk2(kv[0] * fb, kv[1] * fb); ob.y = pk2(kv[2] * fb, kv[3] * fb); ob.z = pk2(kv[4] * fb, kv[5] * fb); ob.w = pk2(kv[6] * fb, kv[7] * fb); \
                *(v4u*)(QC + row * AQKW + cq) = oq; *(v4u*)(KAF + row * AQKW + cq) = of; *(v4u*)(KAB + row * AQKW + cq) = ob; \
                const unsigned fw[4] = {of.x, of.y, of.z, of.w}, bw[4] = {ob.x, ob.y, ob.z, ob.w}; \
                _Pragma("unroll") for (int i = 0; i < 4; ++i) { \
                    Tf[(c8 + 2 * i) * 136 + s] = (unsigned short)(fw[i] & 0xffffu); Tf[(c8 + 2 * i + 1) * 136 + s] = (unsigned short)(fw[i] >> 16); \
                    Tb[(c8 + 2 * i) * 136 + s] = (unsigned short)(bw[i] & 0xffffu); Tb[(c8 + 2 * i + 1) * 136 + s] = (unsigned short)(bw[i] >> 16); } \
                __builtin_amdgcn_sched_barrier(0); } } while (0)
            MO_PROC(qA, kA, 0); __builtin_amdgcn_sched_barrier(0);
            MO_LOAD(qA, kA, 4); __builtin_amdgcn_sched_barrier(0);
            MO_PROC(qB, kB, 2); __builtin_amdgcn_sched_barrier(0);
            MO_LOAD(qB, kB, 6); __builtin_amdgcn_sched_barrier(0);
            MO_PROC(qA, kA, 4); __builtin_amdgcn_sched_barrier(0);
            MO_PROC(qB, kB, 6);
#undef MO_LOAD
#undef MO_PROC
        }
        __syncthreads();
#pragma unroll 2
        for (int p = 0; p < 8; ++p) {
            const int e = p * NTHREADS + F.tid, c = e >> 4, s8 = (e & 15) * 8;
            const v4u tf = *(const LAS v4u*)(Tf + c * 136 + s8), tb = *(const LAS v4u*)(Tb + c * 136 + s8);
            { const size_t to = ((size_t)(b * NCHUNK + j) * AQKW + h * 256 + c) * 128 + s8; *(v4u*)(KAFT + to) = tf; *(v4u*)(KABT + to) = tb; }
        }
    }
    __syncthreads();
}


__device__ __forceinline__ void scan_mfma(const Args& A, Frame& F) {
    const bf16* VT = (const bf16*)(A.ws + WS_VT); const float* DEC = (const float*)(A.ws + WS_DEC);
    bf16* CT = (bf16*)(A.ws + WS_CT); float* NST = (float*)(A.ws + WS_NST);
    LAS unsigned char* Kl = F.lds;
    LAS unsigned char* Vl = F.lds + 65536;
    const int fr = F.lane & 15, fq = F.lane >> 4, wvv = F.tid >> 6, wv = wvv >> 2, wd = wvv & 3;
    const int srow = ((F.tid >> 7) << 3) + (F.tid & 7), sch = (F.tid >> 3) & 15;
    for (int u = F.bid; u < 2 * NBATCH * AH * 4; u += F.G) {
        const int dir = u >> 7, b = (u >> 5) & 3, h = (u >> 2) & 7, vq = u & 3;
        const bf16* KT = (const bf16*)(A.ws + (dir ? WS_KABT : WS_KAFT));
        const bf16* kg = KT + ((size_t)(b * NCHUNK) * AQKW + h * ADK + srow) * 128 + sch * 8;
        const bf16* vg = VT + (size_t)(h * ADV + vq * 128 + srow) * MTOK + (size_t)b * SEQ + sch * 8;
        const bool do_n = (vq == 0) && (wv == 0);
        f32x4 acc[4][4];
#pragma unroll
        for (int a = 0; a < 4; ++a)
#pragma unroll
            for (int c = 0; c < 4; ++c) acc[a][c] = (f32x4){0.f, 0.f, 0.f, 0.f};
        float nacc[4] = {0.f, 0.f, 0.f, 0.f};
        const int j0 = dir ? (NCHUNK - 1) : 0;
        v4u sk[8], sv[4];
#pragma unroll
        for (int p = 0; p < 8; ++p) sk[p] = *(const v4u*)(kg + (size_t)j0 * AQKW * 128 + p * 32 * 128);
#pragma unroll
        for (int p = 0; p < 4; ++p) sv[p] = *(const v4u*)(vg + j0 * 128 + (size_t)(p * 32) * MTOK);
        const float* decp = DEC + (dir * NBATCH * AH + b * AH + h) * NCHUNK;
        float dec = decp[j0];
        __syncthreads();
#pragma unroll 1
        for (int jj = 0; jj < NCHUNK; ++jj) {
            const int j = dir ? (NCHUNK - 1 - jj) : jj; const int jn = dir ? (j - 1) : (j + 1); const bool more = (jj + 1 < NCHUNK);
            const float dec_next = more ? decp[jn] : 1.f;
#pragma unroll
            for (int p = 0; p < 8; ++p) { const int r_ = p * 32 + srow; *(LAS v4u*)(Kl + (sch * 256 + (r_ ^ (((r_ >> 4) & 3) << 2))) * 16) = sk[p]; }
#pragma unroll
            for (int p = 0; p < 4; ++p) *(LAS v4u*)(Vl + (sch * 128 + p * 32 + srow) * 16) = sv[p];
            __syncthreads();
            if (more) {
#pragma unroll
                for (int p = 0; p < 8; ++p) sk[p] = *(const v4u*)(kg + (size_t)jn * AQKW * 128 + p * 32 * 128);
#pragma unroll
                for (int p = 0; p < 4; ++p) sv[p] = *(const v4u*)(vg + jn * 128 + (size_t)(p * 32) * MTOK); }
            const size_t sidx = ((size_t)(dir * NBATCH + b) * AH + h) * NCHUNK + j;
            bf16* ct = CT + (sidx * ADV + vq * 128 + wv * 64 + fr) * ADK + wd * 64 + 16 * fq;
#pragma unroll
            for (int vt = 0; vt < 4; ++vt) { v4u w0, w1;
                w0.x = pk2(acc[0][vt][0], acc[0][vt][1]); w0.y = pk2(acc[0][vt][2], acc[0][vt][3]); w0.z = pk2(acc[1][vt][0], acc[1][vt][1]); w0.w = pk2(acc[1][vt][2], acc[1][vt][3]);
                w1.x = pk2(acc[2][vt][0], acc[2][vt][1]); w1.y = pk2(acc[2][vt][2], acc[2][vt][3]); w1.z = pk2(acc[3][vt][0], acc[3][vt][1]); w1.w = pk2(acc[3][vt][2], acc[3][vt][3]);
                *(v4u*)(ct + (size_t)(vt * 16) * ADK) = w0; *(v4u*)(ct + (size_t)(vt * 16) * ADK + 8) = w1; }
            if (do_n && fq == 0) {
#pragma unroll
                for (int dt = 0; dt < 4; ++dt) NST[sidx * ADK + wd * 64 + 16 * (fr >> 2) + 4 * dt + (fr & 3)] = nacc[dt]; }
#pragma unroll
            for (int dt = 0; dt < 4; ++dt) { nacc[dt] *= dec;
#pragma unroll
                for (int vt = 0; vt < 4; ++vt) acc[dt][vt] *= dec; }
            float np[4] = {0.f, 0.f, 0.f, 0.f};
#pragma unroll
            for (int ks = 0; ks < 4; ++ks) {
                bf16x8 af[4], bq[4];
#pragma unroll
                for (int dt = 0; dt < 4; ++dt) af[dt] = *(const LAS bf16x8*)(Kl + ((4 * ks + fq) * 256 + wd * 64 + 16 * (fr >> 2) + ((4 * dt + (fr & 3)) ^ ((fr >> 2) << 2))) * 16);
#pragma unroll
                for (int vt = 0; vt < 4; ++vt) bq[vt] = *(const LAS bf16x8*)(Vl + ((4 * ks + fq) * 128 + wv * 64 + vt * 16 + fr) * 16);
#pragma unroll
                for (int dt = 0; dt < 4; ++dt)
#pragma unroll
                    for (int vt = 0; vt < 4; ++vt) acc[dt][vt] = MFMA16(af[dt], bq[vt], acc[dt][vt]);
                if (do_n) {
#pragma unroll
                    for (int dt = 0; dt < 4; ++dt) { const v4u w = __builtin_bit_cast(v4u, af[dt]);
                        np[dt] += ((lo16(w.x) + hi16(w.x)) + (lo16(w.y) + hi16(w.y))) + ((lo16(w.z) + hi16(w.z)) + (lo16(w.w) + hi16(w.w))); } }
            }
            if (do_n) {
#pragma unroll
                for (int dt = 0; dt < 4; ++dt) { float t = np[dt]; t += __shfl_xor(t, 16); t += __shfl_xor(t, 32); nacc[dt] += t; } }
            dec = dec_next;
            __syncthreads();
        }
    }
}


__device__ __forceinline__ void natten_lds(const Args& A, Frame& F) {
    const bf16* BQK = (const bf16*)(A.ws + WS_BQK); const bf16* VT = (const bf16*)(A.ws + WS_VT) + (size_t)4096 * MTOK; const bf16* BZ = (const bf16*)(A.ws + WS_BZ);
    bf16* YC = (bf16*)(A.ws + WS_YCAT);
    constexpr int KB = 16 * 64 * 16, VB = 8 * 128 * 16, STG = KB + VB;
    LAS unsigned char* stg = F.lds; LAS float* rpl = (LAS float*)(F.lds + 2 * STG + 256);
    const int fr = F.lane & 15, fq = F.lane >> 4, wvv = F.tid >> 6;
    const int sk = (wvv << 3) + (F.tid & 7), sc = (F.tid >> 3) & 7;
    const int kpos = sk ^ (((sk >> 4) & 1) << 2);
    const int vpos0 = sk, vpos1 = sk + 64;
    const float* kgain = A.in[10]; const float* qgain = A.in[9];
    for (int u0 = F.bid; u0 < NBATCH * BH * 16; u0 += F.G) {
        int u = u0;
        if (F.G == 256) { const int i_ = u0 >> 8, x_ = u0 & 7, s_ = (u0 >> 3) & 31; u = ((i_ * 16 + x_ * 2 + (s_ >> 4)) << 4) | (s_ & 15); }
        const int b = u >> 9, h = (u >> 4) & 31, r0 = (u & 15) * 4;
        const int klo = min(max(r0 - 4, 0), 56), khi = min(max(r0 + 3 - 4, 0), 56) + 7, nst = khi - klo + 1;
        const int r = r0 + (wvv >> 1), qg0 = 2 * (wvv & 1), rs = min(max(r - 4, 0), 56);
        const bf16* kg = BQK + ((size_t)b * SEQ + sk) * 8192 + 4096 + h * BHD + sc * 8;
        const bf16* vg = VT + (size_t)(h * BHD + sk) * MTOK + (size_t)b * SEQ + sc * 8;
        v4u ska0, ska1, sva0, sva1;
#define NA_LOAD(krow_) do { const size_t ko_ = (size_t)(krow_) * 64 * 8192; ska0 = *(const v4u*)(kg + ko_); ska1 = *(const v4u*)(kg + ko_ + 64); sva0 = *(const v4u*)(vg + (krow_) * 64); sva1 = *(const v4u*)(vg + (size_t)64 * MTOK + (krow_) * 64); } while (0)
        NA_LOAD(klo);
        v4u qwr[2][4];
#pragma unroll
        for (int g = 0; g < 2; ++g) { const size_t qtok = (size_t)b * SEQ + r * 64 + 16 * (qg0 + g) + fr;
#pragma unroll
            for (int ks = 0; ks < 4; ++ks) qwr[g][ks] = *(const v4u*)(BQK + qtok * 8192 + h * BHD + 32 * ks + 8 * fq); }
        const float rpv = (F.tid < 465) ? A.in[11][h * 465 + F.tid] : 0.f;
        __builtin_amdgcn_sched_barrier(0);
        __syncthreads();
        if (F.tid < 465) rpl[F.tid] = rpv;
        bf16x8 Qf[2][4];
#pragma unroll
        for (int g = 0; g < 2; ++g) {
            v4u qw[4]; float ss = 0.f;
#pragma unroll
            for (int ks = 0; ks < 4; ++ks) { qw[ks] = qwr[g][ks];
                const float e0 = lo16(qw[ks].x), e1 = hi16(qw[ks].x), e2 = lo16(qw[ks].y), e3 = hi16(qw[ks].y), e4 = lo16(qw[ks].z), e5 = hi16(qw[ks].z), e6 = lo16(qw[ks].w), e7 = hi16(qw[ks].w);
                ss += (e0 * e0 + e1 * e1) + (e2 * e2 + e3 * e3) + (e4 * e4 + e5 * e5) + (e6 * e6 + e7 * e7); }
            ss += __shfl_xor(ss, 16); ss += __shfl_xor(ss, 32);
            const float qs = rsqrtf(ss * (1.f / 128.f) + EPS) * 0.08838834764831845f;
#pragma unroll
            for (int ks = 0; ks < 4; ++ks) { const f32x4 g0 = *(const f32x4*)(qgain + 32 * ks + 8 * fq) * *(const f32x4*)(kgain + 32 * ks + 8 * fq), g1 = *(const f32x4*)(qgain + 32 * ks + 8 * fq + 4) * *(const f32x4*)(kgain + 32 * ks + 8 * fq + 4); v4u o;
                o.x = pk2(lo16(qw[ks].x) * qs * g0[0], hi16(qw[ks].x) * qs * g0[1]); o.y = pk2(lo16(qw[ks].y) * qs * g0[2], hi16(qw[ks].y) * qs * g0[3]);
                o.z = pk2(lo16(qw[ks].z) * qs * g1[0], hi16(qw[ks].z) * qs * g1[1]); o.w = pk2(lo16(qw[ks].w) * qs * g1[2], hi16(qw[ks].w) * qs * g1[3]);
                Qf[g][ks] = __builtin_bit_cast(bf16x8, o); } }
        f32x4 O[2][8]; float l[2] = {0.f, 0.f};
#pragma unroll
        for (int g = 0; g < 2; ++g)
#pragma unroll
            for (int dt = 0; dt < 8; ++dt) O[g][dt] = (f32x4){0.f, 0.f, 0.f, 0.f};
        int dbase[2]; unsigned vmask[2];
#pragma unroll
        for (int g = 0; g < 2; ++g) { const int qg = qg0 + g, c0w = (qg == 0) ? 0 : (qg == 1) ? 8 : (qg == 2) ? 24 : 32; const int qc = 16 * qg + fr, cs = min(max(qc - 8, 0), 48);
            dbase[g] = c0w + 8 * fq - qc + 15; vmask[g] = 0u;
#pragma unroll
            for (int i = 0; i < 8; ++i) { const int kc = c0w + 8 * fq + i; if (kc >= cs && kc < cs + 16) vmask[g] |= 1u << i; } }
#define NA_WRITE(buf_) do { LAS unsigned char* sn_ = stg + (buf_) * STG; \
            const float a0 = lo16(ska0.x), a1 = hi16(ska0.x), a2 = lo16(ska0.y), a3 = hi16(ska0.y), a4 = lo16(ska0.z), a5 = hi16(ska0.z), a6 = lo16(ska0.w), a7 = hi16(ska0.w); \
            const float c0 = lo16(ska1.x), c1 = hi16(ska1.x), c2 = lo16(ska1.y), c3 = hi16(ska1.y), c4 = lo16(ska1.z), c5 = hi16(ska1.z), c6 = lo16(ska1.w), c7 = hi16(ska1.w); \
            float ss_ = ((a0 * a0 + a1 * a1) + (a2 * a2 + a3 * a3)) + ((a4 * a4 + a5 * a5) + (a6 * a6 + a7 * a7)) + ((c0 * c0 + c1 * c1) + (c2 * c2 + c3 * c3)) + ((c4 * c4 + c5 * c5) + (c6 * c6 + c7 * c7)); \
            ss_ += __shfl_xor(ss_, 8); ss_ += __shfl_xor(ss_, 16); ss_ += __shfl_xor(ss_, 32); \
            const float ks_ = rsqrtf(ss_ * (1.f / 128.f) + EPS); v4u k0_, k1_; \
            k0_.x = pk2(a0 * ks_, a1 * ks_); k0_.y = pk2(a2 * ks_, a3 * ks_); k0_.z = pk2(a4 * ks_, a5 * ks_); k0_.w = pk2(a6 * ks_, a7 * ks_); \
            k1_.x = pk2(c0 * ks_, c1 * ks_); k1_.y = pk2(c2 * ks_, c3 * ks_); k1_.z = pk2(c4 * ks_, c5 * ks_); k1_.w = pk2(c6 * ks_, c7 * ks_); \
            *(LAS v4u*)(sn_ + (sc * 64 + kpos) * 16) = k0_; *(LAS v4u*)(sn_ + ((sc + 8) * 64 + kpos) * 16) = k1_; \
            *(LAS v4u*)(sn_ + KB + (sc * 128 + vpos0) * 16) = sva0; *(LAS v4u*)(sn_ + KB + (sc * 128 + vpos1) * 16) = sva1; } while (0)
#define NA_COMPUTE(st_) do { const int kr = klo + (st_); const LAS unsigned char* sb = stg + ((st_) & 1) * STG; \
            if (kr >= rs && kr <= rs + 7) { const int dr = kr - r + 7; \
                _Pragma("unroll") for (int g = 0; g < 2; ++g) { \
                    const int qg = qg0 + g, c0w = (qg == 0) ? 0 : (qg == 1) ? 8 : (qg == 2) ? 24 : 32; \
                    const int k1 = c0w + 8 * (fr >> 2) + (fr & 3), k2 = k1 + 4; \
                    const int p1 = k1 ^ (((k1 >> 4) & 1) << 2), p2 = k2 ^ (((k2 >> 4) & 1) << 2); \
                    f32x4 s1 = {0.f, 0.f, 0.f, 0.f}, s2 = {0.f, 0.f, 0.f, 0.f}; \
                    _Pragma("unroll") for (int ks = 0; ks < 4; ++ks) { const bf16x8 a1 = *(const LAS bf16x8*)(sb + ((4 * ks + fq) * 64 + p1) * 16), a2 = *(const LAS bf16x8*)(sb + ((4 * ks + fq) * 64 + p2) * 16); \
                        s1 = MFMA16(a1, Qf[g][ks], s1); s2 = MFMA16(a2, Qf[g][ks], s2); } \
                    float ps = 0.f; const LAS float* rpr = rpl + dr * 31 + dbase[g]; float bb[8]; \
                    _Pragma("unroll") for (int i = 0; i < 8; ++i) bb[i] = rpr[i]; \
                    _Pragma("unroll") for (int i = 0; i < 4; ++i) { \
                        const float x1 = __expf(s1[i] + bb[i]), x2 = __expf(s2[i] + bb[i + 4]); \
                        const float e1 = ((vmask[g] >> i) & 1u) ? x1 : 0.f, e2 = ((vmask[g] >> (i + 4)) & 1u) ? x2 : 0.f; \
                        s1[i] = e1; s2[i] = e2; ps += e1 + e2; } \
                    l[g] += ps; \
                    v4u pw; pw.x = pk2(s1[0], s1[1]); pw.y = pk2(s1[2], s1[3]); pw.z = pk2(s2[0], s2[1]); pw.w = pk2(s2[2], s2[3]); \
                    const bf16x8 Pf = __builtin_bit_cast(bf16x8, pw); \
                    const int vch = (c0w >> 3) + fq; \
                    _Pragma("unroll") for (int dt = 0; dt < 8; ++dt) { \
                        const bf16x8 av = *(const LAS bf16x8*)(sb + KB + (vch * 128 + dt * 16 + fr) * 16); O[g][dt] = MFMA16(av, Pf, O[g][dt]); } \
                } } } while (0)
        __syncthreads();
        NA_WRITE(0);
        __syncthreads();
#pragma unroll 1
        for (int st = 0; st < nst; ++st) {
            const bool more = (st + 1 < nst);
            if (more) NA_LOAD(klo + st + 1);
            NA_COMPUTE(st);
            if (more) NA_WRITE((st + 1) & 1);
            __syncthreads();
        }
#undef NA_LOAD
#undef NA_WRITE
#undef NA_COMPUTE
        { v2u bzr[2][8];
#pragma unroll
          for (int g = 0; g < 2; ++g) { const size_t qtok = (size_t)b * SEQ + r * 64 + 16 * (qg0 + g) + fr;
#pragma unroll
              for (int dt = 0; dt < 8; ++dt) bzr[g][dt] = *(const v2u*)(BZ + qtok * DM + h * BHD + dt * 16 + 4 * fq); }
          __builtin_amdgcn_sched_barrier(0);
#pragma unroll
          for (int g = 0; g < 2; ++g) { float ls = l[g]; ls += __shfl_xor(ls, 16); ls += __shfl_xor(ls, 32); const float inv = 1.f / ls;
            const size_t qtok = (size_t)b * SEQ + r * 64 + 16 * (qg0 + g) + fr;
#pragma unroll
            for (int dt = 0; dt < 8; ++dt) { const int ch = h * BHD + dt * 16 + 4 * fq; const v2u bz = bzr[g][dt];
                v2u o; o.x = pk2(O[g][dt][0] * inv * lo16(bz.x), O[g][dt][1] * inv * hi16(bz.x)); o.y = pk2(O[g][dt][2] * inv * lo16(bz.y), O[g][dt][3] * inv * hi16(bz.y));
                *(v2u*)(YC + qtok * 8192 + 4096 + ch) = o; } } }
    }
    __syncthreads();
}


constexpr int WS_HD_IS_BQK = 1;
__device__ __forceinline__ void mlstm_out_mfma(const Args& A, Frame& F) {
    const bf16* QC = (const bf16*)(A.ws + WS_QC); const bf16* VT = (const bf16*)(A.ws + WS_VT); const bf16* CT = (const bf16*)(A.ws + WS_CT);
    const float* NST = (const float*)(A.ws + WS_NST); const float* R1 = (const float*)(A.ws + WS_R1); const float* R2 = (const float*)(A.ws + WS_R2);
    bf16* HD = (bf16*)(A.ws + WS_BQK);
    LAS unsigned char* Ql = F.lds; LAS unsigned char* Kl = F.lds + 67584; LAS unsigned char* Sl = Kl;
    LAS float* r1l = (LAS float*)(F.lds + 135168); LAS float* r2l = r1l + 128; LAS float* qnl = r1l + 256; LAS float* dsl = r1l + 384;
    LAS float* nstl = r1l + 640;
    const int fr = F.lane & 15, fq = F.lane >> 4, wvv = F.tid >> 6;
    for (int u0 = F.bid; u0 < 2 * NBATCH * AH * NCHUNK; u0 += F.G) {
        int u = u0;
        if (F.G == 256) { const int i_ = u0 >> 8, x_ = u0 & 7, s_ = (u0 >> 3) & 31; u = ((i_ * 128 + x_ * 16 + (s_ >> 1)) << 1) | (s_ & 1); }
        const int dir = u & 1, j = (u >> 1) & 31, h = (u >> 6) & 7, b = u >> 9;
        const size_t m0 = (size_t)b * SEQ + j * 128; const size_t sidx = ((size_t)(dir * NBATCH + b) * AH + h) * NCHUNK + j;
        const bf16* KA = (const bf16*)(A.ws + (dir ? WS_KAB : WS_KAF));
        __syncthreads();
#pragma unroll
        for (int p = 0; p < 8; ++p) { const int e = p * NTHREADS + F.tid, row = e >> 5, ch = e & 31; const size_t go = (m0 + row) * AQKW + h * ADK + ch * 8;
            const v4u q = *(const v4u*)(QC + go), k = *(const v4u*)(KA + go);
            *(LAS v4u*)(Ql + row * 528 + ch * 16) = q; *(LAS v4u*)(Kl + row * 528 + ch * 16) = k; }
        if (F.tid < 128) { const size_t so = (size_t)(dir * NBATCH * AH + b * AH + h) * SEQ + j * 128 + F.tid; r1l[F.tid] = R1[so]; r2l[F.tid] = R2[so]; }
        else if (F.tid < 192) { const int e = F.tid - 128; *(LAS f32x4*)(nstl + 4 * e) = *(const f32x4*)(NST + sidx * ADK + 4 * e); }
        __syncthreads();
        const int vrow = wvv * 64 + 16 * (fr >> 2) + (fr & 3);
        const bf16* ctb = CT + (sidx * ADV + vrow) * ADK + 8 * fq;
        const bf16* vtb = VT + (size_t)(h * ADV + vrow) * MTOK + m0 + 8 * fq;
        bf16x8 bfr0[4];
#pragma unroll
        for (int vt = 0; vt < 4; ++vt) bfr0[vt] = *(const bf16x8*)(ctb + (size_t)(vt * 4) * ADK);
        { const int t = F.tid >> 2, part = F.tid & 3; const LAS float* nst = nstl + part * 64; float sacc_ = 0.f;
#pragma unroll
          for (int c = 0; c < 8; ++c) { const v4u w = *(const LAS v4u*)(Ql + t * 528 + part * 128 + c * 16); const f32x4 n0 = *(const LAS f32x4*)(nst + c * 8), n1 = *(const LAS f32x4*)(nst + c * 8 + 4);
              sacc_ += lo16(w.x) * n0[0] + hi16(w.x) * n0[1] + lo16(w.y) * n0[2] + hi16(w.y) * n0[3] + lo16(w.z) * n1[0] + hi16(w.z) * n1[1] + lo16(w.w) * n1[2] + hi16(w.w) * n1[3]; }
          sacc_ += __shfl_xor(sacc_, 1); sacc_ += __shfl_xor(sacc_, 2); if (part == 0) qnl[t] = sacc_; }
        f32x4 sacc[2][4];
        { const int tw = wvv >> 1, sw = wvv & 1;
#pragma unroll
          for (int a = 0; a < 2; ++a)
#pragma unroll
              for (int c = 0; c < 4; ++c) sacc[a][c] = (f32x4){0.f, 0.f, 0.f, 0.f};
#pragma unroll 2
          for (int ks = 0; ks < 8; ++ks) {
              bf16x8 qf[2], kf[4];
#pragma unroll
              for (int a = 0; a < 2; ++a) qf[a] = *(const LAS bf16x8*)(Ql + ((2 * tw + a) * 16 + fr) * 528 + (32 * ks + 8 * fq) * 2);
#pragma unroll
              for (int c = 0; c < 4; ++c) kf[c] = *(const LAS bf16x8*)(Kl + ((4 * sw + c) * 16 + fr) * 528 + (32 * ks + 8 * fq) * 2);
#pragma unroll
              for (int a = 0; a < 2; ++a)
#pragma unroll
                  for (int c = 0; c < 4; ++c) sacc[a][c] = MFMA16(kf[c], qf[a], sacc[a][c]);
          }
#pragma unroll
          for (int a = 0; a < 2; ++a) { const int t = (2 * tw + a) * 16 + fr; const float r2v = r2l[t]; float dsum = 0.f;
#pragma unroll
              for (int c = 0; c < 4; ++c)
#pragma unroll
                  for (int i = 0; i < 4; ++i) { const int sx = (4 * sw + c) * 16 + 4 * fq + i; const bool valid = dir ? (sx >= t) : (sx <= t); const float v = valid ? sacc[a][c][i] * r2v : 0.f; sacc[a][c][i] = v; dsum += v; }
              dsum += __shfl_xor(dsum, 16); dsum += __shfl_xor(dsum, 32);
              if (fq == 0) dsl[sw * 128 + t] = dsum; }
          __syncthreads();
#pragma unroll
          for (int a = 0; a < 2; ++a)
#pragma unroll
              for (int c = 0; c < 4; ++c) { v2u w; w.x = pk2(sacc[a][c][0], sacc[a][c][1]); w.y = pk2(sacc[a][c][2], sacc[a][c][3]);
                  *(LAS v2u*)(Sl + ((2 * tw + a) * 16 + fr) * 272 + ((4 * sw + c) * 16 + 4 * fq) * 2) = w; }
        }
        __syncthreads();
        bf16* hd = HD + (size_t)dir * MTOK * DM;
        {
            f32x4 acc[8][4];
#pragma unroll
            for (int tt = 0; tt < 8; ++tt)
#pragma unroll
                for (int vt = 0; vt < 4; ++vt) acc[tt][vt] = (f32x4){0.f, 0.f, 0.f, 0.f};
#define P5_STEP(B_, L_, RS_, ks_) do { _Pragma("unroll") for (int th = 0; th < 2; ++th) { bf16x8 af[4]; \
                _Pragma("unroll") for (int tt = 0; tt < 4; ++tt) af[tt] = *(const LAS bf16x8*)((L_) + ((th * 4 + tt) * 16 + fr) * (RS_) + (32 * (ks_) + 8 * fq) * 2); \
                _Pragma("unroll") for (int tt = 0; tt < 4; ++tt) _Pragma("unroll") for (int vt = 0; vt < 4; ++vt) acc[th * 4 + tt][vt] = MFMA16(B_[vt], af[tt], acc[th * 4 + tt][vt]); } } while (0)
            P5_STEP(bfr0, Ql, 528, 0);
#pragma unroll 1
            for (int ks = 1; ks < 8; ++ks) {
                bf16x8 bfr[4];
#pragma unroll
                for (int vt = 0; vt < 4; ++vt) bfr[vt] = *(const bf16x8*)(ctb + (size_t)(vt * 4) * ADK + 32 * ks);
                P5_STEP(bfr, Ql, 528, ks);
            }
#pragma unroll
            for (int tt = 0; tt < 8; ++tt) { const float r1v = r1l[tt * 16 + fr];
#pragma unroll
                for (int vt = 0; vt < 4; ++vt) acc[tt][vt] *= r1v; }
#pragma unroll 1
            for (int ks = 0; ks < 4; ++ks) {
                bf16x8 bfr[4];
#pragma unroll
                for (int vt = 0; vt < 4; ++vt) bfr[vt] = *(const bf16x8*)(vtb + (size_t)(vt * 4) * MTOK + 32 * ks);
                P5_STEP(bfr, Sl, 272, ks);
            }
#undef P5_STEP
#pragma unroll
            for (int tt = 0; tt < 8; ++tt) { const int t = tt * 16 + fr; const float den = r1l[t] * qnl[t] + dsl[t] + dsl[128 + t]; const float inv = 1.f / fmaxf(fabsf(den), 1.0f);
                bf16* hp = hd + (m0 + t) * DM + h * ADV + wvv * 64 + 16 * fq;
                v4u w0, w1;
                w0.x = pk2(acc[tt][0][0] * inv, acc[tt][0][1] * inv); w0.y = pk2(acc[tt][0][2] * inv, acc[tt][0][3] * inv); w0.z = pk2(acc[tt][1][0] * inv, acc[tt][1][1] * inv); w0.w = pk2(acc[tt][1][2] * inv, acc[tt][1][3] * inv);
                w1.x = pk2(acc[tt][2][0] * inv, acc[tt][2][1] * inv); w1.y = pk2(acc[tt][2][2] * inv, acc[tt][2][3] * inv); w1.z = pk2(acc[tt][3][0] * inv, acc[tt][3][1] * inv); w1.w = pk2(acc[tt][3][2] * inv, acc[tt][3][3] * inv);
                *(v4u*)hp = w0; *(v4u*)(hp + 8) = w1; }
        }
    }
    __syncthreads();
}
__device__ __forceinline__ void mlstm_combine(const Args& A, Frame& F) {
    const bf16* HD0 = (const bf16*)(A.ws + WS_BQK); const bf16* HD1 = HD0 + (size_t)MTOK * DM; const bf16* GA = (const bf16*)(A.ws + WS_GA); bf16* YC = (bf16*)(A.ws + WS_YCAT);
    const int gw = F.bid * NWAVES + F.wave, NGW = F.G * NWAVES;
    const int h = gw & 7;
    const f32x4 g0 = *(const f32x4*)(A.in[8] + h * ADV + F.lane * 8), g1 = *(const f32x4*)(A.in[8] + h * ADV + F.lane * 8 + 4);
    v4u a0[4], c0[4], q0[4], a1[4], c1[4], q1[4];
#define MC_LOAD(a_, c_, q_, it_) do { _Pragma("unroll") for (int k = 0; k < 4; ++k) { const int i_ = (it_) + k * NGW; if (i_ < MTOK * AH) { const size_t off = (size_t)(i_ >> 3) * DM + h * ADV + F.lane * 8; \
            a_[k] = *(const v4u*)(HD0 + off); c_[k] = *(const v4u*)(HD1 + off); q_[k] = *(const v4u*)(GA + off); } } } while (0)
#define MC_PROC(a_, c_, q_, it_) do { _Pragma("unroll") for (int k = 0; k < 4; ++k) { const int i_ = (it_) + k * NGW; if (i_ < MTOK * AH) { const v4u a = a_[k], c = c_[k], g = q_[k]; \
            float x[8] = {lo16(a.x) + lo16(c.x), hi16(a.x) + hi16(c.x), lo16(a.y) + lo16(c.y), hi16(a.y) + hi16(c.y), lo16(a.z) + lo16(c.z), hi16(a.z) + hi16(c.z), lo16(a.w) + lo16(c.w), hi16(a.w) + hi16(c.w)}; \
            float ss = 0.f; _Pragma("unroll") for (int i = 0; i < 8; ++i) ss += x[i] * x[i]; \
            const float rstd = rsqrtf(wave_sum(ss) * (1.f / ADV) + EPS); \
            v4u o; o.x = pk2(x[0] * rstd * g0[0] * lo16(g.x), x[1] * rstd * g0[1] * hi16(g.x)); o.y = pk2(x[2] * rstd * g0[2] * lo16(g.y), x[3] * rstd * g0[3] * hi16(g.y)); \
            o.z = pk2(x[4] * rstd * g1[0] * lo16(g.z), x[5] * rstd * g1[1] * hi16(g.z)); o.w = pk2(x[6] * rstd * g1[2] * lo16(g.w), x[7] * rstd * g1[3] * hi16(g.w)); \
            *(v4u*)(YC + (size_t)(i_ >> 3) * 8192 + h * ADV + F.lane * 8) = o; } } } while (0)
    MC_LOAD(a0, c0, q0, gw);
#pragma unroll 1
    for (int it = gw; it < MTOK * AH; it += 8 * NGW) {
        MC_LOAD(a1, c1, q1, it + 4 * NGW); __builtin_amdgcn_sched_barrier(0);
        MC_PROC(a0, c0, q0, it); __builtin_amdgcn_sched_barrier(0);
        MC_LOAD(a0, c0, q0, it + 8 * NGW); __builtin_amdgcn_sched_barrier(0);
        MC_PROC(a1, c1, q1, it + 4 * NGW); __builtin_amdgcn_sched_barrier(0);
    }
#undef MC_LOAD
#undef MC_PROC
}


__device__ __forceinline__ void sgu_mfma(const Args& A, Frame& F) {
    const bf16* GVT = (const bf16*)(A.ws + WS_GVT); const bf16* UZ = (const bf16*)(A.ws + WS_UZ); const float* VSS = (const float*)(A.ws + WS_VSS);
    bf16* Y1 = (bf16*)(A.ws + WS_Y1);
    LAS unsigned char* Wl = F.lds;
    LAS float* rs = (LAS float*)(F.lds + 32768);
    LAS float* rp = rs + 128;
    const int fr = F.lane & 15, fq = F.lane >> 4, wvv = F.tid >> 6;
    const float* cws = A.in[18]; const float* cbs = A.in[19]; const float* cg = A.in[17];
    for (int u = F.bid; u < NBATCH * NCHUNK * 2; u += F.G) {
        const int b = u >> 6, n = (u >> 1) & 31, gh = u & 1; const size_t m0 = (size_t)b * SEQ + n * 128;
        __syncthreads();
        { const int s = F.tid & 127, part = F.tid >> 7; float a = 0.f;
#pragma unroll
          for (int p = 0; p < 16; ++p) a += VSS[(size_t)(part * 16 + p) * MTOK + m0 + s];
          rp[part * 128 + s] = a; }
        __syncthreads();
        if (F.tid < 128) rs[F.tid] = rsqrtf((rp[F.tid] + rp[128 + F.tid] + rp[256 + F.tid] + rp[384 + F.tid]) * (1.f / CWID) + EPS);
#pragma unroll 1
        for (int gi = 0; gi < 4; ++gi) {
            const int g = gh * 4 + gi;
            __syncthreads();
#pragma unroll
            for (int it = 0; it < 4; ++it) { const int idx = it * NTHREADS + F.tid, t = idx & 127, c = idx >> 7; const float* wp = cws + (size_t)g * 16384 + t * 128 + c * 8;
                const f32x4 w0 = *(const f32x4*)wp, w1 = *(const f32x4*)(wp + 4); const f32x4 r0 = *(const LAS f32x4*)(rs + c * 8), r1 = *(const LAS f32x4*)(rs + c * 8 + 4);
                v4u o; o.x = pk2(w0[0] * r0[0], w0[1] * r0[1]); o.y = pk2(w0[2] * r0[2], w0[3] * r0[3]); o.z = pk2(w1[0] * r1[0], w1[1] * r1[1]); o.w = pk2(w1[2] * r1[2], w1[3] * r1[3]);
                *(LAS v4u*)(Wl + (c * 128 + t) * 16) = o; }
            __syncthreads();
#pragma unroll 1
            for (int q = 0; q < 2; ++q) {
                const int ch0 = g * CGC + (wvv * 2 + q) * 64;
                const bf16* ap = GVT + (size_t)(ch0 + 16 * (fr >> 2) + (fr & 3)) * MTOK + m0 + 8 * fq;
                bf16x8 Af[4][4];
#pragma unroll
                for (int ct = 0; ct < 4; ++ct)
#pragma unroll
                    for (int ks = 0; ks < 4; ++ks) Af[ct][ks] = *(const bf16x8*)(ap + (size_t)(4 * ct) * MTOK + 32 * ks);
                const int chb = ch0 + 16 * fq;
                f32x4 gn[4];
#pragma unroll
                for (int ct = 0; ct < 4; ++ct) gn[ct] = *(const f32x4*)(cg + chb + 4 * ct);
                v4u uzr[8][2]; float bsr[8];
#pragma unroll
                for (int tt = 0; tt < 8; ++tt) { const size_t off = (m0 + tt * 16 + fr) * CWID + chb; uzr[tt][0] = *(const v4u*)(UZ + off); uzr[tt][1] = *(const v4u*)(UZ + off + 8); bsr[tt] = cbs[g * 128 + tt * 16 + fr]; }
                __builtin_amdgcn_sched_barrier(0);
#pragma unroll
                for (int tt = 0; tt < 8; ++tt) {
                    const int t = tt * 16 + fr; const size_t off = (m0 + t) * CWID + chb;
                    const v4u uz0 = uzr[tt][0], uz1 = uzr[tt][1];
                    const float bias = bsr[tt];
                    bf16x8 Bf[4];
#pragma unroll
                    for (int ks = 0; ks < 4; ++ks) Bf[ks] = *(const LAS bf16x8*)(Wl + ((4 * ks + fq) * 128 + t) * 16);
                    f32x4 acc[4];
#pragma unroll
                    for (int ct = 0; ct < 4; ++ct) { acc[ct] = (f32x4){0.f, 0.f, 0.f, 0.f};
#pragma unroll
                        for (int ks = 0; ks < 4; ++ks) acc[ct] = MFMA16(Af[ct][ks], Bf[ks], acc[ct]); }
                    const unsigned uw[8] = {uz0.x, uz0.y, uz0.z, uz0.w, uz1.x, uz1.y, uz1.z, uz1.w};
                    unsigned ow[8];
#pragma unroll
                    for (int ct = 0; ct < 4; ++ct) {
                        ow[2 * ct] = pk2(lo16(uw[2 * ct]) * (gn[ct][0] * acc[ct][0] + bias), hi16(uw[2 * ct]) * (gn[ct][1] * acc[ct][1] + bias));
                        ow[2 * ct + 1] = pk2(lo16(uw[2 * ct + 1]) * (gn[ct][2] * acc[ct][2] + bias), hi16(uw[2 * ct + 1]) * (gn[ct][3] * acc[ct][3] + bias)); }
                    v4u o0, o1; o0.x = ow[0]; o0.y = ow[1]; o0.z = ow[2]; o0.w = ow[3]; o1.x = ow[4]; o1.y = ow[5]; o1.z = ow[6]; o1.w = ow[7];
                    *(v4u*)(Y1 + off) = o0; *(v4u*)(Y1 + off + 8) = o1;
                }
            }
        }
    }
    __syncthreads();
}

__global__ void __launch_bounds__(NTHREADS, 2) mk_fwd(Args A) {
    extern __shared__ __attribute__((aligned(16))) unsigned char lds[];
    Frame F;
    F.lds = (LAS unsigned char*)lds; F.tid = threadIdx.x; F.lane = F.tid & 63; F.wave = __builtin_amdgcn_readfirstlane(F.tid >> 6); F.G = gridDim.x; F.bid = blockIdx.x;
    volatile LAS unsigned* MISC = (volatile LAS unsigned*)(F.lds + MISC_OFF);
    if (F.tid < 64) MISC[F.tid] = 0u;
    __syncthreads();
    XcdBarrier bar; bar.bar = (unsigned*)(A.ws + WS_CTL) + CW_BAR; bar.x = 0; bar.st = nullptr;
    if (N_LAUNCHES == 1) bar = xcd_barrier_post((unsigned*)(A.ws + WS_CTL) + CW_BAR, MISC + 8);
    const int lo = A.ph_lo, hi = A.ph_hi;
#define IN(k) (lo <= (k) && (k) < hi)
#define SEAM(k) do { if (IN(k) && IN((k) + 1)) xcd_barrier(bar); } while (0)
#ifndef DBL_MASK
#define DBL_MASK 0u
#endif
#define REP(k) _Pragma("unroll") for (int rep_ = 0; rep_ <= (int)((DBL_MASK >> (k)) & 1u); ++rep_)
#define REPB() do { if (rep_) xcd_barrier(bar); } while (0)
    float* mod0 = (float*)(A.ws + WS_MOD); float* mod1 = mod0 + 4 * 12288;
    bf16* H = (bf16*)(A.ws + WS_H);
    LAS unsigned char* ring = F.lds;

    if (IN(0)) { REP(16) { ada_items(A, F, rep_); } REP(14) { REPB(); p0_prep(A, F); } } SEAM(0);
    if ((DBL_MASK >> 18) & 1u) { for (int xb_ = 0; xb_ < 20; ++xb_) xcd_barrier(bar); }
    if (IN(1)) REP(1) { REPB(); norm_rows<false>(A, F, A.in[0], A.in[2], mod0, A.in[4], H); } SEAM(1);
    if (IN(2)) REP(2) { REPB();
        gates_mfma(A, F);
        const bf16* W0A = (const bf16*)(A.ws + WS_W0A);
        { pg8::Gemm g{H, W0A, MTOK, 4096, DM}; pg8::StaticOrder S; S.init(MTOK, 4096, F.G, F.bid); pg8::EpiStore<0> E{(bf16*)(A.ws + WS_QKRAW), DM};
          pg8::gemm_phase<pg8::EpiStore<0>, pg8::StaticOrder, true, true>(ring, g, S, E); }
        { pg8::Gemm g{H, W0A + (size_t)4096 * DM, MTOK, 8192, DM}; pg8::StaticOrder S; S.init(MTOK, 8192, F.G, F.bid); pg8::EpiPair<0> E{(bf16*)(A.ws + WS_GA), DM};
          pg8::gemm_phase<pg8::EpiPair<0>, pg8::StaticOrder, true, true>(ring, g, S, E); }
        { pg8::Gemm g{H, W0A + (size_t)12288 * DM, MTOK, 8192, DM}; pg8::StaticOrder S; S.init(MTOK, 8192, F.G, F.bid); pg8::EpiStore<0> E{(bf16*)(A.ws + WS_BQK), 8192};
          pg8::gemm_phase<pg8::EpiStore<0>, pg8::StaticOrder, true, true>(ring, g, S, E); }
        { pg8::Gemm g{H, W0A + (size_t)20480 * DM, MTOK, 4096, DM}; pg8::StaticOrder S; S.init(MTOK, 4096, F.G, F.bid); pg8::EpiStore<1> E{(bf16*)(A.ws + WS_BZ), DM};
          pg8::gemm_phase<pg8::EpiStore<1>, pg8::StaticOrder, true, true>(ring, g, S, E); }
        { pg8::Gemm g{(const bf16*)(A.ws + WS_W0V), H, 8192, MTOK, DM}; pg8::HybridOrder S; S.init(8192, MTOK, F.G, F.bid); S.ns = 5; S.head = (unsigned*)(A.ws + WS_CTL) + CW_QUEUE + 0 * 64; S.slot = (volatile LAS int*)(MISC + 16); pg8::EpiStore<0> E{(bf16*)(A.ws + WS_VT), MTOK};
          pg8::gemm_phase<pg8::EpiStore<0>, pg8::HybridOrder, true, true>(ring, g, S, E); }
    } SEAM(2);
    if (IN(3)) { REP(15) { REPB(); mid_opt(A, F); } }     SEAM(3);
    if (IN(4)) {
        if ((F.bid >> 7) & 1) { REP(13) { REPB(); natten_lds(A, F); } REP(12) { REPB(); scan_mfma(A, F); } }
        else { REP(12) { REPB(); scan_mfma(A, F); } REP(13) { REPB(); natten_lds(A, F); } }
    } SEAM(4);
    if (IN(5)) REP(5) { REPB(); mlstm_out_mfma(A, F); } SEAM(5);
    if (IN(6)) REP(6) { REPB(); mlstm_combine(A, F); } SEAM(6);
    if (IN(7)) REP(7) { REPB();
        pg8::Gemm g{(const bf16*)(A.ws + WS_YCAT), (const bf16*)(A.ws + WS_WOUT0), MTOK, DM, 8192}; pg8::StaticOrder S; S.init(MTOK, DM, F.G, F.bid);
        pg8::EpiResid<false, true> E{A.in[0], (void*)(A.ws + WS_X1), DM, mod0, A.in[4], SEQ};
        pg8::gemm_phase<pg8::EpiResid<false, true>, pg8::StaticOrder, true, true>(ring, g, S, E);
    } SEAM(7);
    if (IN(8)) REP(8) { REPB(); p7_prep1(A, F); norm_rows<true>(A, F, (const void*)(A.ws + WS_X1), A.in[13], mod1, A.in[15], H); } SEAM(8);
    if (IN(9)) REP(9) { REPB();
#ifdef PROBE_CU192
        const int r192 = F.bid >> 3; const bool act192 = (r192 & 3) != 3; const int c192 = (r192 - (r192 >> 2)) * 8 + (F.bid & 7);
        if (act192) {
        { pg8::Gemm g{H, (const bf16*)(A.ws + WS_W1A), MTOK, 16384, DM}; pg8::StaticOrder S; S.init(MTOK, 16384, 192, c192); pg8::EpiPair<1> E{(bf16*)(A.ws + WS_UZ), CWID};
          pg8::gemm_phase<pg8::EpiPair<1>, pg8::StaticOrder, true, true>(ring, g, S, E); }
        { pg8::Gemm g{(const bf16*)(A.ws + WS_W1V), H, 8192, MTOK, DM}; pg8::StaticOrder S; S.init(8192, MTOK, 192, c192); pg8::EpiGeluT E{(bf16*)(A.ws + WS_GVT), MTOK, (float*)(A.ws + WS_VSS), MTOK};
          pg8::gemm_phase<pg8::EpiGeluT, pg8::StaticOrder, true, true>(ring, g, S, E); }
        }
        if (false) {
#else
        {
#endif
        { pg8::Gemm g{H, (const bf16*)(A.ws + WS_W1A), MTOK, 16384, DM}; pg8::StaticOrder S; S.init(MTOK, 16384, F.G, F.bid); pg8::EpiPair<1> E{(bf16*)(A.ws + WS_UZ), CWID};
          pg8::gemm_phase<pg8::EpiPair<1>, pg8::StaticOrder, true, true>(ring, g, S, E); }
        { pg8::Gemm g{(const bf16*)(A.ws + WS_W1V), H, 8192, MTOK, DM}; pg8::HybridOrder S; S.init(8192, MTOK, F.G, F.bid); S.ns = 5; S.head = (unsigned*)(A.ws + WS_CTL) + CW_QUEUE + 1 * 64; S.slot = (volatile LAS int*)(MISC + 16); pg8::EpiGeluT E{(bf16*)(A.ws + WS_GVT), MTOK, (float*)(A.ws + WS_VSS), MTOK};
          pg8::gemm_phase<pg8::EpiGeluT, pg8::HybridOrder, true, true>(ring, g, S, E); }
        }
    } SEAM(9);
    if (IN(10)) REP(10) { REPB(); sgu_mfma(A, F); } SEAM(10);
    if (IN(11)) REP(11) { REPB();
        pg8::Gemm g{(const bf16*)(A.ws + WS_Y1), (const bf16*)(A.ws + WS_WOUT1), MTOK, DM, 8192}; pg8::StaticOrder S; S.init(MTOK, DM, F.G, F.bid);
        pg8::EpiResid<true, false> E{(const void*)(A.ws + WS_X1), (void*)A.out, DM, mod1, A.in[15], SEQ};
        pg8::gemm_phase<pg8::EpiResid<true, false>, pg8::StaticOrder, true, true>(ring, g, S, E);
    }
#undef IN
#undef SEAM
}

extern "C" void kernel_launch(void* const* d_in, const int* in_sizes, int n_in, void* d_out, int out_size, void* d_ws, size_t ws_size, hipStream_t stream) {
    static int grid = 0;
    if (grid == 0) {
        if (n_in != 21 || out_size != MTOK * DM || ws_size < WS_NEED) { fprintf(stderr, "kernel_launch: unexpected shapes (n_in %d, out %d, ws %zu, need %zu); nothing launched\n", n_in, out_size, ws_size, (size_t)WS_NEED); grid = -1; return; }
        int dev = 0, cus = 0, per_cu = 0;
        if (hipGetDevice(&dev) != hipSuccess || hipDeviceGetAttribute(&cus, hipDeviceAttributeMultiprocessorCount, dev) != hipSuccess) { grid = -1; return; }
        if (hipFuncSetAttribute((const void*)mk_fwd, hipFuncAttributeMaxDynamicSharedMemorySize, LDS_BYTES) != hipSuccess) { fprintf(stderr, "kernel_launch: hipFuncSetAttribute failed\n"); grid = -1; return; }
        if (hipOccupancyMaxActiveBlocksPerMultiprocessor(&per_cu, (const void*)mk_fwd, NTHREADS, LDS_BYTES) != hipSuccess || per_cu < 1) { fprintf(stderr, "kernel_launch: occupancy query says %d\n", per_cu); }
        (void)hipGetLastError();
        grid = cus;
    }
    if (grid < 0) return;
    if (hipMemsetAsync((char*)d_ws + WS_CTL, 0, CTL_ZERO_BYTES, stream) != hipSuccess) return;
    Args a{};
    for (int i = 0; i < 21; ++i) a.in[i] = (const float*)d_in[i];
    a.out = (float*)d_out; a.ws = (unsigned char*)d_ws;
    for (int li = 0; li < N_LAUNCHES; ++li) {
        a.ph_lo = (N_LAUNCHES == 1) ? 0 : li; a.ph_hi = (N_LAUNCHES == 1) ? NPHASE : li + 1;
        hipLaunchKernelGGL(mk_fwd, dim3(grid), dim3(NTHREADS), LDS_BYTES, stream, a);
        if (hipPeekAtLastError() != hipSuccess) { fprintf(stderr, "kernel_launch: launch %d failed\n", li); break; }
    }
}
```

```cpp
#include <hip/hip_runtime.h>
#include <cstdio>
#include <cstdint>
#include <type_traits>
#define LAS __attribute__((address_space(3)))
namespace pg8 {
#define PG8_LAS __attribute__((address_space(3)))
typedef unsigned short bf16_t;
typedef short bf16x8 __attribute__((ext_vector_type(8)));
typedef float f32x4 __attribute__((ext_vector_type(4)));
typedef unsigned u32x4 __attribute__((ext_vector_type(4)));
constexpr int BM = 256, BK = 64, HALF = 128, HTB = HALF * BK * 2  , STAGE_BYTES = 8 * HTB, NXCD = 8, WGM = 8;

__host__ __device__ __forceinline__ int lds_byte(int r, int c) { const int st = (r >> 4) * 2 + (c >> 5), rr = r & 15, cc = c & 31, ob = rr * 64 + cc * 2; return st * 1024 + (ob ^ (((ob >> 9) & 1) << 5)); }
__host__ __device__ __forceinline__ void stage_rc(int b, int& R, int& C) { const int st = b / 1024, sb = b % 1024, swz = sb ^ (((sb >> 9) & 1) << 5); R = (st >> 1) * 16 + swz / 64; C = (st & 1) * 32 + (swz % 64) / 2; }
__host__ __device__ __forceinline__ int perm32(int rho) { const int n = rho >> 4, i = rho & 15; return 8 * (i >> 2) + 4 * n + (i & 3); }

struct Unit { int pm, pn; };
struct Gemm { const bf16_t* A; const bf16_t* Bt; int M, N, K; };

struct StaticOrder {
    int nM, nN, nwg, G, c;
    __host__ __device__ void init(int M, int N, int G_, int c_) { nM = M / BM; nN = N / BM; nwg = nM * nN; G = G_; c = c_; }
    __host__ __device__ bool next(int i, Unit& u) const {
        const long L = (long)i * G + c; if (L >= nwg) return false;
        int wgid = (int)L; { const int q = nwg / NXCD, r = nwg % NXCD, xcd = wgid % NXCD, off = wgid / NXCD; wgid = (xcd < r ? xcd * (q + 1) : r * (q + 1) + (xcd - r) * q) + off; }
        const int nig = WGM * nN, gid = wgid / nig, fm = gid * WGM, gsz = (nM - fm) < WGM ? (nM - fm) : WGM;
        u.pm = fm + ((wgid % nig) % gsz); u.pn = (wgid % nig) / gsz; return true;
    }
    __device__ __forceinline__ void a_ready(const Unit&) const {}
    __device__ __forceinline__ void done(const Unit&) const {}
};
struct HybridOrder : StaticOrder {
    int ns; unsigned* head; volatile PG8_LAS int* slot;
    __device__ __forceinline__ bool next(int i, Unit& u) const {
        if (i < ns) return StaticOrder::next(i, u);
        if (threadIdx.x == 0) { const unsigned t = __hip_atomic_fetch_add(head, 1u, __ATOMIC_RELAXED, __HIP_MEMORY_SCOPE_AGENT); slot[i & 1] = (int)t; }
        asm volatile("s_waitcnt lgkmcnt(0)" ::: "memory"); __builtin_amdgcn_s_barrier(); asm volatile("" ::: "memory");
        const long L = (long)ns * G + slot[i & 1]; if (L >= nwg) return false;
        int wgid = (int)L; { const int q = nwg / NXCD, r = nwg % NXCD, xcd = wgid % NXCD, off = wgid / NXCD; wgid = (xcd < r ? xcd * (q + 1) : r * (q + 1) + (xcd - r) * q) + off; }
        const int nig = WGM * nN, gid = wgid / nig, fm = gid * WGM, gsz = (nM - fm) < WGM ? (nM - fm) : WGM;
        u.pm = fm + ((wgid % nig) % gsz); u.pn = (wgid % nig) / gsz; return true;
    }
};
__device__ __forceinline__ unsigned cvt_pk_bf16(float lo, float hi) { unsigned r; asm volatile("v_cvt_pk_bf16_f32 %0, %1, %2" : "=v"(r) : "v"(lo), "v"(hi)); return r; }
typedef float f32x2 __attribute__((ext_vector_type(2)));
__device__ __forceinline__ float act_sigm(float x) { return __builtin_amdgcn_rcpf(1.0f + __builtin_amdgcn_exp2f(-1.4426950408889634f * x)); }
__device__ __forceinline__ float act_silu(float x) { return x * act_sigm(x); }
__device__ __forceinline__ float act_gelu(float x) { const float y = x * (2.3022081985f + 0.1029432367f * x * x); return x * __builtin_amdgcn_rcpf(1.0f + __builtin_amdgcn_exp2f(-y)); }
template <int ACT> struct EpiStore {
    static constexpr bool PERM = true, AFTER_DRAIN = false;
    bf16_t* O; int ldc;
    __device__ __forceinline__ void operator()(const f32x4 (&acc)[2][2][4][2], const Unit& u, int wr, int wc, int fr, int fq) const {
        const int row0 = u.pm * BM + wr * 64 + fr, col0 = u.pn * BM + wc * 32 + 8 * fq;
#pragma unroll
        for (int ai = 0; ai < 2; ++ai)
#pragma unroll
            for (int m = 0; m < 4; ++m) { bf16_t* rowp = O + (size_t)(row0 + ai * HALF + m * 16) * ldc + col0;
#pragma unroll
                for (int bj = 0; bj < 2; ++bj) { f32x4 v0 = acc[ai][bj][m][0], v1 = acc[ai][bj][m][1];
                    if (ACT == 1) {
#pragma unroll
                        for (int j = 0; j < 4; ++j) { v0[j] = act_silu(v0[j]); v1[j] = act_silu(v1[j]); } }
                    if (ACT == 2) {
#pragma unroll
                        for (int j = 0; j < 4; ++j) { v0[j] = act_gelu(v0[j]); v1[j] = act_gelu(v1[j]); } }
                    u32x4 w; w.x = cvt_pk_bf16(v0[0], v0[1]); w.y = cvt_pk_bf16(v0[2], v0[3]); w.z = cvt_pk_bf16(v1[0], v1[1]); w.w = cvt_pk_bf16(v1[2], v1[3]);
                    *(u32x4*)(rowp + bj * HALF) = w; } }
    }
};
template <int KIND> struct EpiPair {
    static constexpr bool PERM = true, AFTER_DRAIN = false;
    bf16_t* O; int ldc;
    __device__ __forceinline__ void operator()(const f32x4 (&acc)[2][2][4][2], const Unit& u, int wr, int wc, int fr, int fq) const {
        const int row0 = u.pm * BM + wr * 64 + fr, col0 = u.pn * HALF + wc * 32 + 8 * fq;
#pragma unroll
        for (int ai = 0; ai < 2; ++ai)
#pragma unroll
            for (int m = 0; m < 4; ++m) { bf16_t* rowp = O + (size_t)(row0 + ai * HALF + m * 16) * ldc + col0;
                f32x4 r0, r1;
#pragma unroll
                for (int j = 0; j < 4; ++j) {
                    const float p0 = acc[ai][0][m][0][j], p1 = acc[ai][0][m][1][j], z0 = acc[ai][1][m][0][j], z1 = acc[ai][1][m][1][j];
                    r0[j] = (KIND == 0 ? act_sigm(p0) : act_gelu(p0)) * act_silu(z0);
                    r1[j] = (KIND == 0 ? act_sigm(p1) : act_gelu(p1)) * act_silu(z1); }
                u32x4 w; w.x = cvt_pk_bf16(r0[0], r0[1]); w.y = cvt_pk_bf16(r0[2], r0[3]); w.z = cvt_pk_bf16(r1[0], r1[1]); w.w = cvt_pk_bf16(r1[2], r1[3]);
                *(u32x4*)rowp = w; }
    }
};
struct EpiGeluT {
    static constexpr bool PERM = true, AFTER_DRAIN = false;
    bf16_t* O; int ldc; float* SS; int ldss;
    __device__ __forceinline__ void operator()(const f32x4 (&acc)[2][2][4][2], const Unit& u, int wr, int wc, int fr, int fq) const {
        const int row0 = u.pm * BM + wr * 64 + fr, col0 = u.pn * BM + wc * 32 + 8 * fq;
        f32x4 ss[2][2];
#pragma unroll
        for (int bj = 0; bj < 2; ++bj) { ss[bj][0] = (f32x4){0.f, 0.f, 0.f, 0.f}; ss[bj][1] = (f32x4){0.f, 0.f, 0.f, 0.f}; }
#pragma unroll
        for (int ai = 0; ai < 2; ++ai)
#pragma unroll
            for (int m = 0; m < 4; ++m) { bf16_t* rowp = O + (size_t)(row0 + ai * HALF + m * 16) * ldc + col0;
#pragma unroll
                for (int bj = 0; bj < 2; ++bj) { f32x4 v0 = acc[ai][bj][m][0], v1 = acc[ai][bj][m][1];
#pragma unroll
                    for (int j = 0; j < 4; ++j) { v0[j] = act_gelu(v0[j]); v1[j] = act_gelu(v1[j]); }
                    ss[bj][0] += v0 * v0; ss[bj][1] += v1 * v1;
                    u32x4 w; w.x = cvt_pk_bf16(v0[0], v0[1]); w.y = cvt_pk_bf16(v0[2], v0[3]); w.z = cvt_pk_bf16(v1[0], v1[1]); w.w = cvt_pk_bf16(v1[2], v1[3]);
                    *(u32x4*)(rowp + bj * HALF) = w; } }
#pragma unroll
        for (int bj = 0; bj < 2; ++bj)
#pragma unroll
            for (int n = 0; n < 2; ++n)
#pragma unroll
                for (int j = 0; j < 4; ++j) { float s = ss[bj][n][j]; s += __shfl_xor(s, 1); s += __shfl_xor(s, 2); s += __shfl_xor(s, 4); s += __shfl_xor(s, 8); ss[bj][n][j] = s; }
        if (fr == 0) { float* sp = SS + (size_t)(2 * u.pm + wr) * ldss + col0;
#pragma unroll
            for (int bj = 0; bj < 2; ++bj) { *(f32x4*)(sp + bj * HALF) = ss[bj][0]; *(f32x4*)(sp + bj * HALF + 4) = ss[bj][1]; } }
    }
};
template <bool BASE_BF16, bool OUT_BF16> struct EpiResid {
    static constexpr bool PERM = false, AFTER_DRAIN = false;
    const void* base; void* out; int ldc; const float* mod; const float* adab; int rows_per_batch;
    __device__ __forceinline__ void operator()(const f32x4 (&acc)[2][2][4][2], const Unit& u, int wr, int wc, int fr, int fq) const {
        const int row0 = u.pm * BM + wr * 64 + fr, col0 = u.pn * BM + wc * 32 + 4 * fq;
        const int b = (u.pm * BM) / rows_per_batch;
        typedef unsigned u32x2 __attribute__((ext_vector_type(2)));
        f32x4 gv[2][2];
#pragma unroll
        for (int bj = 0; bj < 2; ++bj)
#pragma unroll
            for (int n = 0; n < 2; ++n) gv[bj][n] = *(const f32x4*)(mod + (size_t)b * 3 * ldc + 2 * ldc + col0 + bj * HALF + n * 16) + *(const f32x4*)(adab + 2 * ldc + col0 + bj * HALF + n * 16);
        typedef typename std::conditional<BASE_BF16, u32x2, f32x4>::type bv_t;
        bv_t bA[2][2], bB[2][2];
#define ER_LOAD(B_, k_) do { const size_t off_ = (size_t)(row0 + ((k_) >> 2) * HALF + ((k_) & 3) * 16) * ldc + col0; \
            _Pragma("unroll") for (int bj = 0; bj < 2; ++bj) _Pragma("unroll") for (int n = 0; n < 2; ++n) { const size_t o = off_ + bj * HALF + n * 16; \
                if constexpr (BASE_BF16) B_[bj][n] = *(const bv_t*)((const bf16_t*)base + o); else B_[bj][n] = *(const bv_t*)((const float*)base + o); } \
            __builtin_amdgcn_sched_barrier(0); } while (0)
#define ER_STORE(B_, k_) do { const size_t off_ = (size_t)(row0 + ((k_) >> 2) * HALF + ((k_) & 3) * 16) * ldc + col0; \
            _Pragma("unroll") for (int bj = 0; bj < 2; ++bj) _Pragma("unroll") for (int n = 0; n < 2; ++n) { const size_t o = off_ + bj * HALF + n * 16; f32x4 bs; \
                if constexpr (BASE_BF16) { const u32x2 w = B_[bj][n]; bs = (f32x4){__uint_as_float(w.x << 16), __uint_as_float(w.x & 0xffff0000u), __uint_as_float(w.y << 16), __uint_as_float(w.y & 0xffff0000u)}; } \
                else bs = B_[bj][n]; \
                const f32x4 r = bs + gv[bj][n] * acc[(k_) >> 2][bj][(k_) & 3][n]; \
                if (OUT_BF16) { u32x2 w; w.x = cvt_pk_bf16(r[0], r[1]); w.y = cvt_pk_bf16(r[2], r[3]); *(u32x2*)((bf16_t*)out + o) = w; } \
                else *(f32x4*)((float*)out + o) = r; } \
            __builtin_amdgcn_sched_barrier(0); } while (0)
        ER_LOAD(bA, 0);
        ER_LOAD(bB, 1); ER_STORE(bA, 0);
        ER_LOAD(bA, 2); ER_STORE(bB, 1);
        ER_LOAD(bB, 3); ER_STORE(bA, 2);
        ER_LOAD(bA, 4); ER_STORE(bB, 3);
        ER_LOAD(bB, 5); ER_STORE(bA, 4);
        ER_LOAD(bA, 6); ER_STORE(bB, 5);
        ER_LOAD(bB, 7); ER_STORE(bA, 6);
        ER_STORE(bB, 7);
#undef ER_LOAD
#undef ER_STORE
    }
};

template <class Epi, class Sched, bool ALIGN_EPI = false, bool SP2 = false>
__device__ __forceinline__ void gemm_phase(PG8_LAS unsigned char* lds, const Gemm g, const Sched& S, const Epi& E) {
    const int tid = threadIdx.x, wid = __builtin_amdgcn_readfirstlane(tid >> 6), lane = tid & 63, wr = wid >> 2, wc = wid & 3, fr = lane & 15, fq = lane >> 4;
    const int K = g.K, nt = K / BK;
    unsigned voffA[2], voffB[2];
#pragma unroll
    for (int i = 0; i < 2; ++i) { int R, C; stage_rc(tid * 16 + i * 8192, R, C); const int Rb = Epi::PERM ? ((R & ~31) + perm32(R & 31)) : R;
        voffA[i] = (unsigned)(R * K + C) * 2u; voffB[i] = (unsigned)(Rb * K + C) * 2u; }
    const size_t kstep = (size_t)(BK * 2);
    const size_t hstep = (size_t)HALF * K * 2;
    const size_t tstep = 2 * hstep;
    const unsigned ldsw = (unsigned)wid * 1024u;
    const int aoff = lds_byte(wr * 64 + fr, fq * 8), boff = lds_byte(wc * 32 + fr, fq * 8);
#define PG8_SA(b, h) (((b) * 2 + (h)) * HTB)
#define PG8_SB(b, h) ((4 + (b) * 2 + (h)) * HTB)
#define PG8_STAGE(bufoff, gbase, voff) do { _Pragma("unroll") for (int _i = 0; _i < 2; ++_i) \
        __builtin_amdgcn_global_load_lds((const unsigned*)((const char*)(gbase) + (voff)[_i]), (PG8_LAS unsigned*)(lds + (bufoff) + ldsw + _i * 8192), 16, 0, 0); } while (0)
#define PG8_LDA(dst, b, h) do { _Pragma("unroll") for (int m = 0; m < 4; ++m) _Pragma("unroll") for (int k = 0; k < 2; ++k) dst[m][k] = *(const PG8_LAS bf16x8*)(lds + PG8_SA(b, h) + aoff + m * 2048 + k * 1024); } while (0)
#define PG8_LDB(dst, b, h) do { _Pragma("unroll") for (int n = 0; n < 2; ++n) _Pragma("unroll") for (int k = 0; k < 2; ++k) dst[n][k] = *(const PG8_LAS bf16x8*)(lds + PG8_SB(b, h) + boff + n * 2048 + k * 1024); } while (0)
#define PG8_MMA(ai, bj, At, Bt) do { __builtin_amdgcn_s_setprio(1); _Pragma("unroll") for (int m = 0; m < 4; ++m) _Pragma("unroll") for (int n = 0; n < 2; ++n) _Pragma("unroll") for (int k = 0; k < 2; ++k) \
        acc[ai][bj][m][n] = __builtin_amdgcn_mfma_f32_16x16x32_bf16(Bt[n][k], At[m][k], acc[ai][bj][m][n], 0, 0, 0); __builtin_amdgcn_s_setprio(0); } while (0)
#define PG8_WAIT_V(n) asm volatile("s_waitcnt vmcnt(" #n ")" ::: "memory")
#define PG8_WAIT_L(n) asm volatile("s_waitcnt lgkmcnt(" #n ")" ::: "memory")
#define PG8_BAR __builtin_amdgcn_s_barrier()
#define PG8_SCHED __builtin_amdgcn_sched_barrier(0)
    Unit cur, nxt; int ui = 0;
    if (!S.next(0, cur)) return;
    f32x4 acc[2][2][4][2];
#pragma unroll
    for (int a = 0; a < 2; ++a)
#pragma unroll
        for (int b = 0; b < 2; ++b)
#pragma unroll
            for (int m = 0; m < 4; ++m)
#pragma unroll
                for (int n = 0; n < 2; ++n) acc[a][b][m][n] = (f32x4){0.f, 0.f, 0.f, 0.f};
    bf16x8 At[4][2], B0[2][2], B1[2][2];
    const char* cA = (const char*)g.A + (size_t)cur.pm * tstep; const char* cB = (const char*)g.Bt + (size_t)cur.pn * tstep;
    S.a_ready(cur);
    if constexpr (SP2) {
        PG8_STAGE(PG8_SB(0, 0), cB, voffB); PG8_STAGE(PG8_SB(0, 1), cB + hstep, voffB); PG8_STAGE(PG8_SA(0, 0), cA, voffA); PG8_STAGE(PG8_SA(0, 1), cA + hstep, voffA);
        if (wr == 1) PG8_BAR;
        PG8_WAIT_V(2); PG8_BAR;
        PG8_STAGE(PG8_SB(1, 0), cB + kstep, voffB); PG8_STAGE(PG8_SA(1, 0), cA + kstep, voffA); PG8_STAGE(PG8_SB(1, 1), cB + hstep + kstep, voffB);
        PG8_WAIT_V(6); PG8_BAR;
    } else {
        PG8_STAGE(PG8_SB(0, 0), cB, voffB); PG8_STAGE(PG8_SA(0, 0), cA, voffA); PG8_STAGE(PG8_SB(0, 1), cB + hstep, voffB); PG8_STAGE(PG8_SA(0, 1), cA + hstep, voffA);
        if (wr == 1) PG8_BAR;
        PG8_WAIT_V(4); PG8_BAR;
        PG8_STAGE(PG8_SB(1, 0), cB + kstep, voffB); PG8_STAGE(PG8_SA(1, 0), cA + kstep, voffA); PG8_STAGE(PG8_SB(1, 1), cB + hstep + kstep, voffB);
        PG8_WAIT_V(6); PG8_BAR;
    }
    for (;;) {
        const bool has_next = S.next(ui + 1, nxt);
        const char* nA = has_next ? (const char*)g.A + (size_t)nxt.pm * tstep : cA; const char* nB = has_next ? (const char*)g.Bt + (size_t)nxt.pn * tstep : cB;
        for (int t = 0; t < nt; t += 2) {
            const bool last = (t == nt - 2);
            const char* a1 = cA + (size_t)(t + 1) * kstep;
            const char* a2 = last ? nA : cA + (size_t)(t + 2) * kstep; const char* b2 = last ? nB : cB + (size_t)(t + 2) * kstep;
            const char* a3 = a2 + kstep; const char* b3 = b2 + kstep;
            if (last && has_next) S.a_ready(nxt);
            if constexpr (SP2) {
            PG8_LDB(B0, 0, 0); PG8_LDB(B1, 0, 1); PG8_SCHED; PG8_LDA(At, 0, 0); PG8_STAGE(PG8_SA(1, 1), a1 + hstep, voffA);
            PG8_WAIT_V(8); PG8_WAIT_L(0); PG8_BAR; PG8_MMA(0, 0, At, B0); PG8_MMA(0, 1, At, B1); PG8_BAR; PG8_SCHED;
            PG8_LDA(At, 0, 1); PG8_STAGE(PG8_SB(0, 0), b2, voffB); PG8_STAGE(PG8_SB(0, 1), b2 + hstep, voffB); PG8_STAGE(PG8_SA(0, 0), a2, voffA);
            PG8_WAIT_V(8); PG8_WAIT_L(0); PG8_BAR; PG8_MMA(1, 0, At, B0); PG8_MMA(1, 1, At, B1); PG8_BAR; PG8_SCHED;
            PG8_LDB(B0, 1, 0); PG8_LDB(B1, 1, 1); PG8_SCHED; PG8_LDA(At, 1, 0); PG8_STAGE(PG8_SA(0, 1), a2 + hstep, voffA);
            PG8_WAIT_V(8); PG8_WAIT_L(0); PG8_BAR; PG8_MMA(0, 0, At, B0); PG8_MMA(0, 1, At, B1); PG8_BAR; PG8_SCHED;
            PG8_LDA(At, 1, 1); PG8_STAGE(PG8_SB(1, 0), b3, voffB); PG8_STAGE(PG8_SB(1, 1), b3 + hstep, voffB); PG8_STAGE(PG8_SA(1, 0), a3, voffA);
            PG8_WAIT_V(8); PG8_WAIT_L(0); PG8_BAR; PG8_MMA(1, 0, At, B0); PG8_MMA(1, 1, At, B1); PG8_BAR; PG8_SCHED;
            } else {
            PG8_LDB(B0, 0, 0); PG8_SCHED; PG8_LDA(At, 0, 0); PG8_STAGE(PG8_SA(1, 1), a1 + hstep, voffA);
            PG8_WAIT_L(8); PG8_BAR; PG8_WAIT_L(0); PG8_MMA(0, 0, At, B0); PG8_BAR; PG8_SCHED;
            PG8_LDB(B1, 0, 1); PG8_STAGE(PG8_SB(0, 0), b2, voffB);
            PG8_BAR; PG8_WAIT_L(0); PG8_MMA(0, 1, At, B1); PG8_BAR;
            PG8_LDA(At, 0, 1); PG8_STAGE(PG8_SA(0, 0), a2, voffA);
            PG8_BAR; PG8_WAIT_L(0); PG8_MMA(1, 0, At, B0); PG8_BAR; PG8_SCHED;
            PG8_STAGE(PG8_SB(0, 1), b2 + hstep, voffB);
            PG8_WAIT_V(6); PG8_BAR; PG8_MMA(1, 1, At, B1); PG8_BAR;
            PG8_LDB(B0, 1, 0); PG8_SCHED; PG8_LDA(At, 1, 0); PG8_STAGE(PG8_SA(0, 1), a2 + hstep, voffA);
            PG8_WAIT_L(8); PG8_BAR; PG8_WAIT_L(0); PG8_MMA(0, 0, At, B0); PG8_BAR; PG8_SCHED;
            PG8_LDB(B1, 1, 1); PG8_STAGE(PG8_SB(1, 0), b3, voffB);
            PG8_BAR; PG8_WAIT_L(0); PG8_MMA(0, 1, At, B1); PG8_BAR;
            PG8_LDA(At, 1, 1); PG8_STAGE(PG8_SA(1, 0), a3, voffA);
            PG8_BAR; PG8_WAIT_L(0); PG8_MMA(1, 0, At, B0); PG8_BAR; PG8_SCHED;
            PG8_STAGE(PG8_SB(1, 1), b3 + hstep, voffB);
            PG8_WAIT_V(6); PG8_BAR; PG8_MMA(1, 1, At, B1); PG8_BAR;
            }
        }
        if constexpr (ALIGN_EPI) { if (wr == 0) PG8_BAR; }
        if constexpr (!Epi::AFTER_DRAIN) { E(acc, cur, wr, wc, fr, fq); S.done(cur); }
        if (!has_next) break;
#pragma unroll
        for (int a = 0; a < 2; ++a)
#pragma unroll
            for (int b = 0; b < 2; ++b)
#pragma unroll
                for (int m = 0; m < 4; ++m)
#pragma unroll
                    for (int n = 0; n < 2; ++n) acc[a][b][m][n] = (f32x4){0.f, 0.f, 0.f, 0.f};
        cur = nxt; cA = nA; cB = nB; ++ui;
        if constexpr (ALIGN_EPI) { if (wr == 1) PG8_BAR; }
    }
    PG8_WAIT_V(0);
    if constexpr (!ALIGN_EPI) { if (wr == 0) PG8_BAR; }
    PG8_BAR;
    if constexpr (Epi::AFTER_DRAIN) { E.fused(acc, cur, wr, wc, fr, fq, lds, wid, lane); S.done(cur); }
#undef PG8_SA
#undef PG8_SB
#undef PG8_STAGE
#undef PG8_LDA
#undef PG8_LDB
#undef PG8_MMA
#undef PG8_WAIT_V
#undef PG8_WAIT_L
#undef PG8_BAR
#undef PG8_SCHED
}
}

#define XB_TMO      128
#define XB_XCNT(j)  (256  + 64 * (j))
#define XB_XSUB(j)  (1280 + 64 * (j))
#define XB_XGEN(j)  (2304 + 64 * (j))
#define XB_TOP      3328
#define XB_TOPGEN   3392
#define XCD_BAR_WORDS 3456
#define XB_SPIN_CAP (1u << 18)

__device__ __forceinline__ unsigned xb_ld(unsigned* p)              { return __hip_atomic_load(p, __ATOMIC_RELAXED, __HIP_MEMORY_SCOPE_AGENT); }
__device__ __forceinline__ unsigned xb_add(unsigned* p, unsigned v) { return __hip_atomic_fetch_add(p, v, __ATOMIC_RELAXED, __HIP_MEMORY_SCOPE_AGENT); }
__device__ __forceinline__ unsigned xb_xcc_id() { return (unsigned)__builtin_amdgcn_s_getreg((3 << 11) | 20) & 0xFu; }
#define XB_SPIN(cond, bar) do { unsigned _sp = 0; while (cond) { __builtin_amdgcn_s_sleep(1); \
    if ((++_sp & 255u) == 0u) { if (xb_ld(&(bar)[XB_TMO])) break; if (_sp > XB_SPIN_CAP) { atomicAdd(&(bar)[XB_TMO], 1u); break; } } } } while (0)

struct XcdBarrier {
    unsigned* bar; unsigned x;
    volatile LAS unsigned* st;
};

__device__ __forceinline__ XcdBarrier xcd_barrier_post(unsigned* bar, volatile LAS unsigned* st) {
    XcdBarrier b; b.bar = bar; b.x = xb_xcc_id(); b.st = st;
    if (threadIdx.x == 0) (void)xb_add(&bar[XB_XCNT(b.x)], 1u);
    return b;
}
__device__ __forceinline__ void xcd_barrier_complete(unsigned* bar, unsigned x, unsigned& nloc, unsigned& nx) {
    const unsigned G = gridDim.x * gridDim.y * gridDim.z;
    unsigned sum, cnt, mine, sp = 0u;
    for (;;) {
        sum = 0u; cnt = 0u; mine = 0u;
#pragma unroll
        for (unsigned j = 0; j < 16; ++j) { const unsigned c = xb_ld(&bar[XB_XCNT(j)]); sum += c; cnt += (c > 0u) ? 1u : 0u; mine = (j == x) ? c : mine; }
        if (sum == G) break;
        __builtin_amdgcn_s_sleep(1);
        if ((++sp & 255u) == 0u) { if (xb_ld(&bar[XB_TMO])) break; if (sp > XB_SPIN_CAP) { atomicAdd(&bar[XB_TMO], 1u); break; } }
    }
    nloc = mine > 0u ? mine : 1u; nx = cnt > 0u ? cnt : 1u;
}

__device__ __forceinline__ void xcd_barrier(const XcdBarrier& b) {
    asm volatile("s_waitcnt vmcnt(0)" ::: "memory");
    __syncthreads();
    if (threadIdx.x == 0) {
        unsigned* bar = b.bar;
        __builtin_amdgcn_s_waitcnt(0);
        unsigned nloc = b.st[0], nx = b.st[1];
        if (nloc == 0u) { xcd_barrier_complete(bar, b.x, nloc, nx); b.st[0] = nloc; b.st[1] = nx; }
        const unsigned old = xb_add(&bar[XB_XSUB(b.x)], 1u);
        const unsigned gen = old / nloc;
        if (old + 1u == (gen + 1u) * nloc) {
            __builtin_amdgcn_fence(__ATOMIC_RELEASE, "agent");
            asm volatile("s_waitcnt vmcnt(0)" ::: "memory");
            const unsigned og = xb_add(&bar[XB_TOP], 1u);
            const unsigned tg = og / nx;
            if (og + 1u == (tg + 1u) * nx) xb_add(&bar[XB_TOPGEN], 1u);
            else XB_SPIN(xb_ld(&bar[XB_TOPGEN]) == tg, bar);
            __builtin_amdgcn_fence(__ATOMIC_ACQUIRE, "agent");
            xb_add(&bar[XB_XGEN(b.x)], 1u);
            asm volatile("s_waitcnt vmcnt(0)" ::: "memory");
        } else {
            XB_SPIN(xb_ld(&bar[XB_XGEN(b.x)]) == gen, bar);
            __builtin_amdgcn_fence(__ATOMIC_ACQUIRE, "agent");
            asm volatile("s_waitcnt vmcnt(0)" ::: "memory");
        }
    }
    __syncthreads();
}

constexpr int DM = 4096, NBATCH = 4, SEQ = 4096, MTOK = NBATCH * SEQ;
constexpr int AH = 8, ADV = 512, ADK = 256, AQKW = 2048;
constexpr int BH = 32, BHD = 128;
constexpr int L0COLS = 32800;
constexpr int CWID = 8192, CGR = 8, CCH = 128, CGC = 1024;
constexpr int NCHUNK = SEQ / 128;
constexpr float EPS = 1e-6f;
constexpr int C_AQ = 0, C_AK = 2048, C_AV = 4096, C_AO = 8192, C_AZ = 12288, C_GT = 16384, C_BQ = 16416, C_BK = 20512, C_BV = 24608, C_BZ = 28704;

#ifndef MK_N_LAUNCHES
#define MK_N_LAUNCHES 1
#endif
constexpr int NPHASE = 12;
constexpr int N_LAUNCHES = MK_N_LAUNCHES;

constexpr size_t MiB = 1u << 20;
constexpr size_t WS_CTL = 0, CTL_ZERO_BYTES = 1 * MiB;
constexpr int CW_BAR = 1024;
constexpr int CW_QUEUE = 8192;
constexpr size_t WS_MOD = 64 * 1024;
constexpr size_t WS_WG = 1 * MiB;
constexpr size_t WS_GATES = 2 * MiB;
constexpr size_t WS_R1 = 4 * MiB, WS_R2 = 5 * MiB;
constexpr size_t WS_DEC = 6 * MiB;
constexpr size_t WS_NST = 7 * MiB;
constexpr size_t WS_VSS = 10 * MiB;
constexpr size_t WS_W0A = 16 * MiB;
constexpr size_t WS_W0V = 208 * MiB;
constexpr size_t WS_H = 272 * MiB;
constexpr size_t WS_QKRAW = 400 * MiB;
constexpr size_t WS_CT = 16 * MiB;
constexpr size_t WS_WOUT0 = 528 * MiB;
constexpr size_t WS_GA = 592 * MiB;
constexpr size_t WS_BQK = 720 * MiB;
constexpr size_t WS_BZ = 976 * MiB;
constexpr size_t WS_VT = 1104 * MiB;
constexpr size_t WS_QC = 1360 * MiB;
constexpr size_t WS_KAF = 1424 * MiB, WS_KAB = 1488 * MiB;
constexpr size_t WS_KAFT = 1552 * MiB, WS_KABT = 1616 * MiB;
constexpr size_t WS_YCAT = 1680 * MiB;
constexpr size_t WS_END0 = 1936 * MiB;
constexpr size_t WS_W1A = 16 * MiB;
constexpr size_t WS_W1V = 144 * MiB;
constexpr size_t WS_WOUT1 = 208 * MiB;
constexpr size_t WS_UZ = 592 * MiB;
constexpr size_t WS_GVT = 848 * MiB;
constexpr size_t WS_Y1 = 1104 * MiB;
constexpr size_t WS_X1 = 1360 * MiB;
constexpr size_t WS_NEED = WS_END0;

constexpr int RING_BYTES = 131072;
constexpr int MISC_OFF = 147456 - 256;
constexpr int LDS_BYTES = 147456;
constexpr int NWAVES = 8, NTHREADS = 512;

#define GAS __attribute__((address_space(1)))
typedef unsigned short bf16;
typedef unsigned v4u __attribute__((ext_vector_type(4)));
typedef unsigned v2u __attribute__((ext_vector_type(2)));
typedef float f32x4 __attribute__((ext_vector_type(4)));
#define LDS_WAIT() asm volatile("s_waitcnt lgkmcnt(0)" ::: "memory")
__device__ __forceinline__ float bf2f(unsigned short b) { return __uint_as_float(((unsigned)b) << 16); }
__device__ __forceinline__ unsigned f2bf(float f) { unsigned u = __float_as_uint(f); return (u + 0x7fffu + ((u >> 16) & 1u)) >> 16; }
__device__ __forceinline__ unsigned pk2(float lo, float hi) { unsigned r; asm("v_cvt_pk_bf16_f32 %0, %1, %2" : "=v"(r) : "v"(lo), "v"(hi)); return r; }
__device__ __forceinline__ float lo16(unsigned w) { return __uint_as_float(w << 16); }
__device__ __forceinline__ float hi16(unsigned w) { return __uint_as_float(w & 0xffff0000u); }
__device__ __forceinline__ float siluf_(float x) { return x * __builtin_amdgcn_rcpf(1.0f + __builtin_amdgcn_exp2f(-1.4426950408889634f * x)); }
__device__ __forceinline__ float logsigf_(float x) { return fminf(x, 0.f) - log1pf(__expf(-fabsf(x))); }
__device__ __forceinline__ float wave_sum(float v) {
#pragma unroll
    for (int o = 1; o < 64; o <<= 1) v += __shfl_xor(v, o);
    return v;
}

struct Args {
    const float* in[21]; float* out; unsigned char* ws; int ph_lo, ph_hi;
};
struct Frame { LAS unsigned char* lds; int tid, lane, wave, G, bid; };

__device__ __forceinline__ void transpose_item(const float* W, int ldw, int K, bf16* WT, int dst_row0, int src_col0, int kb, LAS float* scr, int lane) {
    const int k0 = 64 * kb;
    float tv[32];
    const float* wp = W + (size_t)(k0 + (lane >> 5)) * ldw + src_col0 + (lane & 31);
#pragma unroll
    for (int i = 0; i < 32; ++i) tv[i] = __builtin_nontemporal_load(wp + (size_t)(2 * i) * ldw);
#pragma unroll
    for (int i = 0; i < 32; ++i) scr[(2 * i + (lane >> 5)) * 33 + (lane & 31)] = tv[i];
    LDS_WAIT(); asm volatile("" ::: "memory");
    const int c = lane & 7;
#pragma unroll
    for (int j = 0; j < 4; ++j) { const int n = (lane >> 3) + 8 * j; const LAS float* s = scr + (8 * c) * 33 + n;
        v4u o; o.x = pk2(s[0 * 33], s[1 * 33]); o.y = pk2(s[2 * 33], s[3 * 33]); o.z = pk2(s[4 * 33], s[5 * 33]); o.w = pk2(s[6 * 33], s[7 * 33]);
        *(v4u*)(WT + (size_t)(dst_row0 + n) * K + k0 + 8 * c) = o; }
    LDS_WAIT(); asm volatile("" ::: "memory");
}
__device__ __forceinline__ int map_w0a(int n) {
    if (n < 4096) return n;
    if (n < 12288) { const int t = (n - 4096) >> 8, w = (n - 4096) & 255; return (w < 128 ? C_AO : C_AZ) + 128 * t + (w & 127); }
    if (n < 20480) return C_BQ + (n - 12288);
    return C_BZ + (n - 20480);
}
__device__ __forceinline__ int map_w1a(int n) {
    const int t = n >> 8, w = n & 255; return (w < 128 ? 0 : 16384) + 128 * t + (w & 127);
}
__device__ __forceinline__ void ada_items(const Args& A, Frame& F, int dummy) {
    LAS float* sc = (LAS float*)(F.lds);
    for (int it = F.bid; it < 2 * 64 * 6; it += F.G) {
        const int layer = it / 384, r = it % 384, kb = r / 6, cg = r % 6, k0 = kb * 64;
        const float* w = layer ? A.in[14] : A.in[3];
        float* mod = (float*)(A.ws + WS_MOD) + (size_t)(layer + 2 * dummy) * 4 * 12288;
        __syncthreads();
        if (F.tid < 256) { const int b = F.tid >> 6, kk = F.tid & 63; sc[b * 64 + kk] = siluf_(A.in[1][b * DM + k0 + kk]); }
        __syncthreads();
        const int j0 = cg * 2048 + 4 * F.tid;
        f32x4 a0 = {0.f, 0.f, 0.f, 0.f}, a1 = a0, a2 = a0, a3 = a0;
#pragma unroll 8
        for (int kk = 0; kk < 64; ++kk) { const f32x4 wv = __builtin_nontemporal_load((const f32x4*)(w + (size_t)(k0 + kk) * 12288 + j0));
            a0 += wv * sc[kk]; a1 += wv * sc[64 + kk]; a2 += wv * sc[128 + kk]; a3 += wv * sc[192 + kk]; }
#pragma unroll
        for (int i = 0; i < 4; ++i) { atomicAdd(mod + 0 * 12288 + j0 + i, a0[i]); atomicAdd(mod + 1 * 12288 + j0 + i, a1[i]); atomicAdd(mod + 2 * 12288 + j0 + i, a2[i]); atomicAdd(mod + 3 * 12288 + j0 + i, a3[i]); }
    }
    __syncthreads();
}
__device__ __forceinline__ void p0_prep(const Args& A, Frame& F) {
    LAS float* scr = (LAS float*)(F.lds + 4096 + F.wave * 8704);
    const int gw = F.bid * NWAVES + F.wave, NGW = F.G * NWAVES;
    bf16* W0A = (bf16*)(A.ws + WS_W0A); bf16* W0V = (bf16*)(A.ws + WS_W0V); bf16* WO0 = (bf16*)(A.ws + WS_WOUT0);
    constexpr int I_A = 64 * 768, I_V = 64 * 256, I_O = 128 * 128, I_G = 64;
    for (int it = gw; it < I_A + I_V + I_O + I_G; it += NGW) {
        int r = it;
        if (r < I_G) { transpose_item(A.in[5], L0COLS, DM, (bf16*)(A.ws + WS_WG), 0, C_GT, r, scr, F.lane); continue; } r -= I_G;
        if (r < I_A) { const int kb = r / 768, db = r % 768; transpose_item(A.in[5], L0COLS, DM, W0A, 32 * db, map_w0a(32 * db), kb, scr, F.lane); continue; } r -= I_A;
        if (r < I_V) { const int kb = r / 256, db = r % 256, n = 32 * db; transpose_item(A.in[5], L0COLS, DM, W0V, n, n < 4096 ? C_AV + n : C_BV + (n - 4096), kb, scr, F.lane); continue; } r -= I_V;
        { const int kb = r / 128, db = r % 128; transpose_item(A.in[12], DM, 8192, WO0, 32 * db, 32 * db, kb, scr, F.lane); }
    }
}
__device__ __forceinline__ void p7_prep1(const Args& A, Frame& F) {
    LAS float* scr = (LAS float*)(F.lds + 4096 + F.wave * 8704);
    const int gw = F.bid * NWAVES + F.wave, NGW = F.G * NWAVES;
    bf16* W1A = (bf16*)(A.ws + WS_W1A); bf16* W1V = (bf16*)(A.ws + WS_W1V); bf16* WO1 = (bf16*)(A.ws + WS_WOUT1);
    constexpr int I_A = 64 * 512, I_V = 64 * 256, I_O = 128 * 128;
    unsigned* qh = (unsigned*)(A.ws + WS_CTL) + CW_QUEUE + 4 * 512;
    (void)gw; (void)NGW;
    for (;;) {
        unsigned tk = 0u; if (F.lane == 0) tk = __hip_atomic_fetch_add(qh, 1u, __ATOMIC_RELAXED, __HIP_MEMORY_SCOPE_AGENT);
        tk = (unsigned)__builtin_amdgcn_readfirstlane((int)tk);
        if (tk >= (unsigned)((I_A + I_V + I_O) / 16)) break;
#pragma unroll 1
      for (int it = (int)tk * 16; it < (int)tk * 16 + 16; ++it) {
        int r = it;
        if (r < I_A) { const int kb = r / 512, db = r % 512; transpose_item(A.in[16], 3 * CWID, DM, W1A, 32 * db, map_w1a(32 * db), kb, scr, F.lane); continue; } r -= I_A;
        if (r < I_V) { const int kb = r / 256, db = r % 256; transpose_item(A.in[16], 3 * CWID, DM, W1V, 32 * db, 8192 + 32 * db, kb, scr, F.lane); continue; } r -= I_V;
        { const int kb = r / 128, db = r % 128; transpose_item(A.in[20], DM, 8192, WO1, 32 * db, 32 * db, kb, scr, F.lane); }
      }
    }
}
template <bool IN_BF16> __device__ __forceinline__ void norm_rows(const Args& A, Frame& F, const void* xin, const float* g, const float* mod, const float* adab, bf16* H) {
    LAS float* PA = (LAS float*)F.lds; LAS float* PS = PA + NBATCH * DM;
    __syncthreads();
    for (int e = F.tid; e < NBATCH * DM; e += NTHREADS) { const int b = e >> 12, c = e & (DM - 1);
        PA[e] = g[c] * (1.0f + mod[(size_t)b * 12288 + DM + c] + adab[DM + c]); PS[e] = mod[(size_t)b * 12288 + c] + adab[c]; }
    __syncthreads();
    const int gw = F.bid * NWAVES + F.wave, NGW = F.G * NWAVES;
    typedef typename std::conditional<IN_BF16, v4u, f32x4>::type xv_t;
    constexpr int NV = IN_BF16 ? 8 : 16;
    xv_t xa[NV], xb[NV];
#define NR_LOAD(X_, m_) do { if ((m_) < MTOK) { _Pragma("unroll") for (int j = 0; j < 8; ++j) { \
            if (IN_BF16) X_[j] = *(const xv_t*)((const bf16*)xin + (size_t)(m_) * DM + 512 * j + 8 * F.lane); \
            else { X_[2 * j] = *(const xv_t*)((const float*)xin + (size_t)(m_) * DM + 512 * j + 8 * F.lane); X_[2 * j + 1] = *(const xv_t*)((const float*)xin + (size_t)(m_) * DM + 512 * j + 8 * F.lane + 4); } } } } while (0)
#define NR_PROC(X_, m_) do { if ((m_) < MTOK) { float v[8][8]; float s = 0.f; \
            _Pragma("unroll") for (int j = 0; j < 8; ++j) { \
                if (IN_BF16) { const v4u w = __builtin_bit_cast(v4u, X_[j]); v[j][0] = lo16(w.x); v[j][1] = hi16(w.x); v[j][2] = lo16(w.y); v[j][3] = hi16(w.y); v[j][4] = lo16(w.z); v[j][5] = hi16(w.z); v[j][6] = lo16(w.w); v[j][7] = hi16(w.w); } \
                else { const f32x4 p0 = __builtin_bit_cast(f32x4, X_[IN_BF16 ? j : 2 * j]), p1 = __builtin_bit_cast(f32x4, X_[IN_BF16 ? j : 2 * j + 1]); v[j][0] = p0[0]; v[j][1] = p0[1]; v[j][2] = p0[2]; v[j][3] = p0[3]; v[j][4] = p1[0]; v[j][5] = p1[1]; v[j][6] = p1[2]; v[j][7] = p1[3]; } \
                s += ((v[j][0] * v[j][0] + v[j][1] * v[j][1]) + (v[j][2] * v[j][2] + v[j][3] * v[j][3])) + ((v[j][4] * v[j][4] + v[j][5] * v[j][5]) + (v[j][6] * v[j][6] + v[j][7] * v[j][7])); } \
            const float rstd = rsqrtf(wave_sum(s) * (1.f / DM) + EPS); const int pb = ((m_) / SEQ) * DM + 8 * F.lane; \
            _Pragma("unroll") for (int j = 0; j < 8; ++j) { const f32x4 a0 = *(const LAS f32x4*)(PA + pb + 512 * j), a1 = *(const LAS f32x4*)(PA + pb + 512 * j + 4), s0 = *(const LAS f32x4*)(PS + pb + 512 * j), s1 = *(const LAS f32x4*)(PS + pb + 512 * j + 4); \
                v4u o; o.x = pk2(v[j][0] * rstd * a0[0] + s0[0], v[j][1] * rstd * a0[1] + s0[1]); o.y = pk2(v[j][2] * rstd * a0[2] + s0[2], v[j][3] * rstd * a0[3] + s0[3]); \
                o.z = pk2(v[j][4] * rstd * a1[0] + s1[0], v[j][5] * rstd * a1[1] + s1[1]); o.w = pk2(v[j][6] * rstd * a1[2] + s1[2], v[j][7] * rstd * a1[3] + s1[3]); \
                *(v4u*)(H + (size_t)(m_) * DM + 512 * j + 8 * F.lane) = o; } } } while (0)
    NR_LOAD(xa, gw);
#pragma unroll 1
    for (int m = gw; m < MTOK; m += 2 * NGW) {
        NR_LOAD(xb, m + NGW); __builtin_amdgcn_sched_barrier(0);
        NR_PROC(xa, m); __builtin_amdgcn_sched_barrier(0);
        NR_LOAD(xa, m + 2 * NGW); __builtin_amdgcn_sched_barrier(0);
        NR_PROC(xb, m + NGW); __builtin_amdgcn_sched_barrier(0);
    }
#undef NR_LOAD
#undef NR_PROC
    __syncthreads();
}


typedef short bf16x8 __attribute__((ext_vector_type(8)));
#define MFMA16(a, b, c) __builtin_amdgcn_mfma_f32_16x16x32_bf16((a), (b), (c), 0, 0, 0)
__device__ __forceinline__ void gates_mfma(const Args& A, Frame& F) {
    const bf16* H = (const bf16*)(A.ws + WS_H); const bf16* WG = (const bf16*)(A.ws + WS_WG); float* GT = (float*)(A.ws + WS_GATES);
    const int fr = F.lane & 15, fq = F.lane >> 4, mt = F.wave >> 1, nt = F.wave & 1;
    for (int rb = F.bid; rb < MTOK / 64; rb += F.G) {
        const bf16* ap = H + (size_t)(rb * 64 + mt * 16 + fr) * DM + 8 * fq; const bf16* bp = WG + (size_t)(nt * 16 + fr) * DM + 8 * fq;
        f32x4 acc = {0.f, 0.f, 0.f, 0.f};
#pragma unroll 16
        for (int ks = 0; ks < DM / 32; ++ks) { const bf16x8 a = *(const bf16x8*)(ap + 32 * ks), b = *(const bf16x8*)(bp + 32 * ks); acc = MFMA16(a, b, acc); }
        const float bias = A.in[7][nt * 16 + fr];
#pragma unroll
        for (int i = 0; i < 4; ++i) GT[(size_t)(rb * 64 + mt * 16 + 4 * fq + i) * 32 + nt * 16 + fr] = acc[i] + bias;
    }
}


__device__ __forceinline__ float wave_incl_scan(float x, int lane) {
#pragma unroll
    for (int o = 1; o < 64; o <<= 1) { const float y = __shfl_up(x, o); if (lane >= o) x += y; }
    return x;
}
__device__ __forceinline__ void mid_opt(const Args& A, Frame& F) {
    const float* GT = (const float*)(A.ws + WS_GATES);
    float* R1 = (float*)(A.ws + WS_R1); float* R2 = (float*)(A.ws + WS_R2); float* DEC = (float*)(A.ws + WS_DEC);
    const bf16* QKR = (const bf16*)(A.ws + WS_QKRAW);
    bf16* QC = (bf16*)(A.ws + WS_QC); bf16* KAF = (bf16*)(A.ws + WS_KAF); bf16* KAB = (bf16*)(A.ws + WS_KAB); bf16* KAFT = (bf16*)(A.ws + WS_KAFT); bf16* KABT = (bf16*)(A.ws + WS_KABT);
    LAS unsigned short* Tf = (LAS unsigned short*)F.lds;
    LAS unsigned short* Tb = (LAS unsigned short*)(F.lds + 69632);
    LAS float* L = (LAS float*)(F.lds + 139264);
    LAS float *af = L, *ab = L + 128, *wt = L + 256;
    LAS float* cwl = L + 264;
    const float* cw = A.in[6];
    for (int it = F.bid; it < NBATCH * AH * NCHUNK; it += F.G) {
        const int b = it >> 8, h = (it >> 5) & 7, j = it & 31; const int m0 = b * SEQ + j * 128;
            const int s_lo = F.tid >> 5, c8 = (F.tid & 31) * 8; const int cq = h * 256 + c8, ck = 2048 + h * 256 + c8;
            v4u qA[2][3], kA[2][3], qB[2][3], kB[2][3];
#define MO_LOAD(Q_, K_, p0_) do { int sl_ = s_lo; asm volatile("" : "+v"(sl_)); _Pragma("unroll") for (int pp = 0; pp < 2; ++pp) { const int s = ((p0_) + pp) * 16 + sl_, tok = j * 128 + s; const size_t row = (size_t)(m0 + s); const v4u z4 = {0u, 0u, 0u, 0u}; \
                Q_[pp][0] = tok > 0 ? *(const v4u*)(QKR + (row - 1) * DM + cq) : z4; Q_[pp][1] = *(const v4u*)(QKR + row * DM + cq); Q_[pp][2] = tok < SEQ - 1 ? *(const v4u*)(QKR + (row + 1) * DM + cq) : z4; \
                K_[pp][0] = tok > 0 ? *(const v4u*)(QKR + (row - 1) * DM + ck) : z4; K_[pp][1] = *(const v4u*)(QKR + row * DM + ck); K_[pp][2] = tok < SEQ - 1 ? *(const v4u*)(QKR + (row + 1) * DM + ck) : z4; } } while (0)
            MO_LOAD(qA, kA, 0); MO_LOAD(qB, kB, 2);
        float cwv[3];
#pragma unroll
        for (int k = 0; k < 3; ++k) { const int c = F.tid; cwv[k] = cw[k * DM + (c < 256 ? h * 256 + c : 2048 + h * 256 + (c - 256))]; }
        float g_if = 0.f, g_ff = 0.f, g_ib = 0.f, g_fb = 0.f;
        if (F.tid < 128) { const float* gr = GT + (size_t)(m0 + F.tid) * 32; g_if = gr[h]; g_ff = gr[8 + h]; g_ib = gr[16 + h]; g_fb = gr[24 + h]; }
        __builtin_amdgcn_sched_barrier(0);
        __syncthreads();
#pragma unroll
        for (int k = 0; k < 3; ++k) cwl[k * 512 + F.tid] = cwv[k];
        float igf = 0.f, igb = 0.f, lff = 0.f, lfb = 0.f, pf = 0.f, pb = 0.f;
        if (F.tid < 128) {
            igf = g_if; lff = logsigf_(g_ff); igb = g_ib; lfb = logsigf_(g_fb);
            pf = wave_incl_scan(lff, F.lane); pb = wave_incl_scan(lfb, F.lane);
            if (F.tid == 63) { wt[0] = pf; wt[1] = pb; } }
        __syncthreads();
        if (F.tid < 128) { if (F.tid >= 64) { pf += wt[0]; pb += wt[1]; } if (F.tid == 127) { wt[2] = pf; wt[3] = pb; } }
        __syncthreads();
        if (F.tid < 128) { const int s = F.tid; const float gLf = wt[2], gLb = wt[3];
            const float gf = pf, gb = gLb - pb + lfb;
            af[s] = __expf(igf + gLf - gf); ab[s] = __expf(igb + gLb - gb);
            const size_t o = (size_t)(b * AH + h) * SEQ + j * 128 + s, od = (size_t)NBATCH * AH * SEQ;
            R1[o] = __expf(gf); R2[o] = __expf(gf - gLf); R1[od + o] = __expf(gb); R2[od + o] = __expf(gb - gLb);
            if (s == 0) { DEC[(b * AH + h) * NCHUNK + j] = __expf(gLf); DEC[NBATCH * AH * NCHUNK + (b * AH + h) * NCHUNK + j] = __expf(gLb); } }
        __syncthreads();
        {
#define MO_PROC(Q_, K_, p0_) do { int sl_ = s_lo; asm volatile("" : "+v"(sl_)); _Pragma("unroll") for (int pp = 0; pp < 2; ++pp) { const int s = ((p0_) + pp) * 16 + sl_; const size_t row = (size_t)(m0 + s); \
                const unsigned qa[4] = {Q_[pp][0].x, Q_[pp][0].y, Q_[pp][0].z, Q_[pp][0].w}, qb[4] = {Q_[pp][1].x, Q_[pp][1].y, Q_[pp][1].z, Q_[pp][1].w}, qd[4] = {Q_[pp][2].x, Q_[pp][2].y, Q_[pp][2].z, Q_[pp][2].w}; \
                const unsigned ka[4] = {K_[pp][0].x, K_[pp][0].y, K_[pp][0].z, K_[pp][0].w}, kb[4] = {K_[pp][1].x, K_[pp][1].y, K_[pp][1].z, K_[pp][1].w}, kd[4] = {K_[pp][2].x, K_[pp][2].y, K_[pp][2].z, K_[pp][2].w}; \
                float qv[8], kv[8]; \
                _Pragma("unroll") for (int i = 0; i < 4; ++i) { \
                    const f32x4 t0 = *(const LAS f32x4*)(cwl + c8 + 4 * (i >> 1)), t1 = *(const LAS f32x4*)(cwl + 512 + c8 + 4 * (i >> 1)), t2 = *(const LAS f32x4*)(cwl + 1024 + c8 + 4 * (i >> 1)); \
                    const f32x4 u0 = *(const LAS f32x4*)(cwl + 256 + c8 + 4 * (i >> 1)), u1 = *(const LAS f32x4*)(cwl + 768 + c8 + 4 * (i >> 1)), u2 = *(const LAS f32x4*)(cwl + 1280 + c8 + 4 * (i >> 1)); \
                    const int e0 = 2 * (i & 1); \
                    qv[2 * i] = siluf_(t0[e0] * lo16(qa[i]) + t1[e0] * lo16(qb[i]) + t2[e0] * lo16(qd[i])) * 0.0625f; \
                    qv[2 * i + 1] = siluf_(t0[e0 + 1] * hi16(qa[i]) + t1[e0 + 1] * hi16(qb[i]) + t2[e0 + 1] * hi16(qd[i])) * 0.0625f; \
                    kv[2 * i] = siluf_(u0[e0] * lo16(ka[i]) + u1[e0] * lo16(kb[i]) + u2[e0] * lo16(kd[i])); \
                    kv[2 * i + 1] = siluf_(u0[e0 + 1] * hi16(ka[i]) + u1[e0 + 1] * hi16(kb[i]) + u2[e0 + 1] * hi16(kd[i])); } \
                const float fa = af[s], fb = ab[s]; \
                v4u oq, of, ob; \
                oq.x = pk2(qv[0], qv[1]); oq.y = pk2(qv[2], qv[3]); oq.z = pk2(qv[4], qv[5]); oq.w = pk2(qv[6], qv[7]); \
                of.x = pk2(kv[0] * fa, kv[1] * fa); of.y = pk2(kv[2] * fa, kv[3] * fa); of.z = pk2(kv[4] * fa, kv[5] * fa); of.w = pk2(kv[6] * fa, kv[7] * fa); \
                ob.x = pk2(kv[0] * fb, kv[1] * fb); ob.y = pk2(kv[2] * fb, kv[3] * fb); ob.z = pk2(kv[4] * fb, kv[5] * fb); ob.w = pk2(kv[6] * fb, kv[7] * fb); \
                *(v4u*)(QC + row * AQKW + cq) = oq; *(v4u*)(KAF + row * AQKW + cq) = of; *(v4u*)(KAB + row * AQKW + cq) = ob; \
                const unsigned fw[4] = {of.x, of.y, of.z, of.w}, bw[4] = {ob.x, ob.y, ob.z, ob.w}; \
                _Pragma("unroll") for (int i = 0; i < 4; ++i) { \
                    Tf[(c8 + 2 * i) * 136 + s] = (unsigned short)(fw[i] & 0xffffu); Tf[(c8 + 2 * i + 1) * 136 + s] = (unsigned short)(fw[i] >> 16); \
                    Tb[(c8 + 2 * i) * 136 + s] = (unsigned short)(bw[i] & 0xffffu); Tb[(c8 + 2 * i + 1) * 136 + s] = (unsigned short)(bw[i] >> 16); } \
                __builtin_amdgcn_sched_barrier(0); } } while (0)
            MO_PROC(qA, kA, 0); __builtin_amdgcn_sched_barrier(0);
            MO_LOAD(qA, kA, 4); __builtin_amdgcn_sched_barrier(0);
            MO_PROC(qB, kB, 2); __builtin_amdgcn_sched_barrier(0);
            MO_LOAD(qB, kB, 6); __builtin_amdgcn_sched_barrier(0);
            MO_PROC(qA, kA, 4); __builtin_amdgcn_sched_barrier(0);
            MO_PROC(qB, kB, 6);
#undef MO_LOAD
#undef MO_PROC
        }
        __syncthreads();
#pragma unroll 2
        for (int p = 0; p < 8; ++p) {
            const int e = p * NTHREADS + F.tid, c = e >> 4, s8 = (e & 15) * 8;
            const v4u tf = *(const LAS v4u*)(Tf + c * 136 + s8), tb = *(const LAS v4u*)(Tb + c * 136 + s8);
            { const size_t to = ((size_t)(b * NCHUNK + j) * AQKW + h * 256 + c) * 128 + s8; *(v4u*)(KAFT + to) = tf; *(v4u*)(KABT + to) = tb; }
        }
    }
    __syncthreads();
}


__device__ __forceinline__ void scan_mfma(const Args& A, Frame& F) {
    const bf16* VT = (const bf16*)(A.ws + WS_VT); const float* DEC = (const float*)(A.ws + WS_DEC);
    bf16* CT = (bf16*)(A.ws + WS_CT); float* NST = (float*)(A.ws + WS_NST);
    LAS unsigned char* Kl = F.lds;
    LAS unsigned char* Vl = F.lds + 65536;
    const int fr = F.lane & 15, fq = F.lane >> 4, wvv = F.tid >> 6, wv = wvv >> 2, wd = wvv & 3;
    const int srow = ((F.tid >> 7) << 3) + (F.tid & 7), sch = (F.tid >> 3) & 15;
    for (int u = F.bid; u < 2 * NBATCH * AH * 4; u += F.G) {
        const int dir = u >> 7, b = (u >> 5) & 3, h = (u >> 2) & 7, vq = u & 3;
        const bf16* KT = (const bf16*)(A.ws + (dir ? WS_KABT : WS_KAFT));
        const bf16* kg = KT + ((size_t)(b * NCHUNK) * AQKW + h * ADK + srow) * 128 + sch * 8;
        const bf16* vg = VT + (size_t)(h * ADV + vq * 128 + srow) * MTOK + (size_t)b * SEQ + sch * 8;
        const bool do_n = (vq == 0) && (wv == 0);
        f32x4 acc[4][4];
#pragma unroll
        for (int a = 0; a < 4; ++a)
#pragma unroll
            for (int c = 0; c < 4; ++c) acc[a][c] = (f32x4){0.f, 0.f, 0.f, 0.f};
        float nacc[4] = {0.f, 0.f, 0.f, 0.f};
        const int j0 = dir ? (NCHUNK - 1) : 0;
        v4u sk[8], sv[4];
#pragma unroll
        for (int p = 0; p < 8; ++p) sk[p] = *(const v4u*)(kg + (size_t)j0 * AQKW * 128 + p * 32 * 128);
#pragma unroll
        for (int p = 0; p < 4; ++p) sv[p] = *(const v4u*)(vg + j0 * 128 + (size_t)(p * 32) * MTOK);
        const float* decp = DEC + (dir * NBATCH * AH + b * AH + h) * NCHUNK;
        float dec = decp[j0];
        __syncthreads();
#pragma unroll 1
        for (int jj = 0; jj < NCHUNK; ++jj) {
            const int j = dir ? (NCHUNK - 1 - jj) : jj; const int jn = dir ? (j - 1) : (j + 1); const bool more = (jj + 1 < NCHUNK);
            const float dec_next = more ? decp[jn] : 1.f;
#pragma unroll
            for (int p = 0; p < 8; ++p) { const int r_ = p * 32 + srow; *(LAS v4u*)(Kl + (sch * 256 + (r_ ^ (((r_ >> 4) & 3) << 2))) * 16) = sk[p]; }
#pragma unroll
            for (int p = 0; p < 4; ++p) *(LAS v4u*)(Vl + (sch * 128 + p * 32 + srow) * 16) = sv[p];
            __syncthreads();
            if (more) {
#pragma unroll
                for (int p = 0; p < 8; ++p) sk[p] = *(const v4u*)(kg + (size_t)jn * AQKW * 128 + p * 32 * 128);
#pragma unroll
                for (int p = 0; p < 4; ++p) sv[p] = *(const v4u*)(vg + jn * 128 + (size_t)(p * 32) * MTOK); }
            const size_t sidx = ((size_t)(dir * NBATCH + b) * AH + h) * NCHUNK + j;
            bf16* ct = CT + (sidx * ADV + vq * 128 + wv * 64 + fr) * ADK + wd * 64 + 16 * fq;
#pragma unroll
            for (int vt = 0; vt < 4; ++vt) { v4u w0, w1;
                w0.x = pk2(acc[0][vt][0], acc[0][vt][1]); w0.y = pk2(acc[0][vt][2], acc[0][vt][3]); w0.z = pk2(acc[1][vt][0], acc[1][vt][1]); w0.w = pk2(acc[1][vt][2], acc[1][vt][3]);
                w1.x = pk2(acc[2][vt][0], acc[2][vt][1]); w1.y = pk2(acc[2][vt][2], acc[2][vt][3]); w1.z = pk2(acc[3][vt][0], acc[3][vt][1]); w1.w = pk2(acc[3][vt][2], acc[3][vt][3]);
                *(v4u*)(ct + (size_t)(vt * 16) * ADK) = w0; *(v4u*)(ct + (size_t)(vt * 16) * ADK + 8) = w1; }
            if (do_n && fq == 0) {
#pragma unroll
                for (int dt = 0; dt < 4; ++dt) NST[sidx * ADK + wd * 64 + 16 * (fr >> 2) + 4 * dt + (fr & 3)] = nacc[dt]; }
#pragma unroll
            for (int dt = 0; dt < 4; ++dt) { nacc[dt] *= dec;
#pragma unroll
                for (int vt = 0; vt < 4; ++vt) acc[dt][vt] *= dec; }
            float np[4] = {0.f, 0.f, 0.f, 0.f};
#pragma unroll
            for (int ks = 0; ks < 4; ++ks) {
                bf16x8 af[4], bq[4];
#pragma unroll
                for (int dt = 0; dt < 4; ++dt) af[dt] = *(const LAS bf16x8*)(Kl + ((4 * ks + fq) * 256 + wd * 64 + 16 * (fr >> 2) + ((4 * dt + (fr & 3)) ^ ((fr >> 2) << 2))) * 16);
#pragma unroll
                for (int vt = 0; vt < 4; ++vt) bq[vt] = *(const LAS bf16x8*)(Vl + ((4 * ks + fq) * 128 + wv * 64 + vt * 16 + fr) * 16);
#pragma unroll
                for (int dt = 0; dt < 4; ++dt)
#pragma unroll
                    for (int vt = 0; vt < 4; ++vt) acc[dt][vt] = MFMA16(af[dt], bq[vt], acc[dt][vt]);
                if (do_n) {
#pragma unroll
                    for (int dt = 0; dt < 4; ++dt) { const v4u w = __builtin_bit_cast(v4u, af[dt]);
                        np[dt] += ((lo16(w.x) + hi16(w.x)) + (lo16(w.y) + hi16(w.y))) + ((lo16(w.z) + hi16(w.z)) + (lo16(w.w) + hi16(w.w))); } }
            }
            if (do_n) {
#pragma unroll
                for (int dt = 0; dt < 4; ++dt) { float t = np[dt]; t += __shfl_xor(t, 16); t += __shfl_xor(t, 32); nacc[dt] += t; } }
            dec = dec_next;
            __syncthreads();
        }
    }
}


__device__ __forceinline__ void natten_lds(const Args& A, Frame& F) {
    const bf16* BQK = (const bf16*)(A.ws + WS_BQK); const bf16* VT = (const bf16*)(A.ws + WS_VT) + (size_t)4096 * MTOK; const bf16* BZ = (const bf16*)(A.ws + WS_BZ);
    bf16* YC = (bf16*)(A.ws + WS_YCAT);
    constexpr int KB = 16 * 64 * 16, VB = 8 * 128 * 16, STG = KB + VB;
    LAS unsigned char* stg = F.lds; LAS float* rpl = (LAS float*)(F.lds + 2 * STG + 256);
    const int fr = F.lane & 15, fq = F.lane >> 4, wvv = F.tid >> 6;
    const int sk = (wvv << 3) + (F.tid & 7), sc = (F.tid >> 3) & 7;
    const int kpos = sk ^ (((sk >> 4) & 1) << 2);
    const int vpos0 = sk, vpos1 = sk + 64;
    const float* kgain = A.in[10]; const float* qgain = A.in[9];
    for (int u0 = F.bid; u0 < NBATCH * BH * 16; u0 += F.G) {
        int u = u0;
        if (F.G == 256) { const int i_ = u0 >> 8, x_ = u0 & 7, s_ = (u0 >> 3) & 31; u = ((i_ * 16 + x_ * 2 + (s_ >> 4)) << 4) | (s_ & 15); }
        const int b = u >> 9, h = (u >> 4) & 31, r0 = (u & 15) * 4;
        const int klo = min(max(r0 - 4, 0), 56), khi = min(max(r0 + 3 - 4, 0), 56) + 7, nst = khi - klo + 1;
        const int r = r0 + (wvv >> 1), qg0 = 2 * (wvv & 1), rs = min(max(r - 4, 0), 56);
        const bf16* kg = BQK + ((size_t)b * SEQ + sk) * 8192 + 4096 + h * BHD + sc * 8;
        const bf16* vg = VT + (size_t)(h * BHD + sk) * MTOK + (size_t)b * SEQ + sc * 8;
        v4u ska0, ska1, sva0, sva1;
#define NA_LOAD(krow_) do { const size_t ko_ = (size_t)(krow_) * 64 * 8192; ska0 = *(const v4u*)(kg + ko_); ska1 = *(const v4u*)(kg + ko_ + 64); sva0 = *(const v4u*)(vg + (krow_) * 64); sva1 = *(const v4u*)(vg + (size_t)64 * MTOK + (krow_) * 64); } while (0)
        NA_LOAD(klo);
        v4u qwr[2][4];
#pragma unroll
        for (int g = 0; g < 2; ++g) { const size_t qtok = (size_t)b * SEQ + r * 64 + 16 * (qg0 + g) + fr;
#pragma unroll
            for (int ks = 0; ks < 4; ++ks) qwr[g][ks] = *(const v4u*)(BQK + qtok * 8192 + h * BHD + 32 * ks + 8 * fq); }
        const float rpv = (F.tid < 465) ? A.in[11][h * 465 + F.tid] : 0.f;
        __builtin_amdgcn_sched_barrier(0);
        __syncthreads();
        if (F.tid < 465) rpl[F.tid] = rpv;
        bf16x8 Qf[2][4];
#pragma unroll
        for (int g = 0; g < 2; ++g) {
            v4u qw[4]; float ss = 0.f;
#pragma unroll
            for (int ks = 0; ks < 4; ++ks) { qw[ks] = qwr[g][ks];
                const float e0 = lo16(qw[ks].x), e1 = hi16(qw[ks].x), e2 = lo16(qw[ks].y), e3 = hi16(qw[ks].y), e4 = lo16(qw[ks].z), e5 = hi16(qw[ks].z), e6 = lo16(qw[ks].w), e7 = hi16(qw[ks].w);
                ss += (e0 * e0 + e1 * e1) + (e2 * e2 + e3 * e3) + (e4 * e4 + e5 * e5) + (e6 * e6 + e7 * e7); }
            ss += __shfl_xor(ss, 16); ss += __shfl_xor(ss, 32);
            const float qs = rsqrtf(ss * (1.f / 128.f) + EPS) * 0.08838834764831845f;
#pragma unroll
            for (int ks = 0; ks < 4; ++ks) { const f32x4 g0 = *(const f32x4*)(qgain + 32 * ks + 8 * fq) * *(const f32x4*)(kgain + 32 * ks + 8 * fq), g1 = *(const f32x4*)(qgain + 32 * ks + 8 * fq + 4) * *(const f32x4*)(kgain + 32 * ks + 8 * fq + 4); v4u o;
                o.x = pk2(lo16(qw[ks].x) * qs * g0[0], hi16(qw[ks].x) * qs * g0[1]); o.y = pk2(lo16(qw[ks].y) * qs * g0[2], hi16(qw[ks].y) * qs * g0[3]);
                o.z = pk2(lo16(qw[ks].z) * qs * g1[0], hi16(qw[ks].z) * qs * g1[1]); o.w = pk2(lo16(qw[ks].w) * qs * g1[2], hi16(qw[ks].w) * qs * g1[3]);
                Qf[g][ks] = __builtin_bit_cast(bf16x8, o); } }
        f32x4 O[2][8]; float l[2] = {0.f, 0.f};
#pragma unroll
        for (int g = 0; g < 2; ++g)
#pragma unroll
            for (int dt = 0; dt < 8; ++dt) O[g][dt] = (f32x4){0.f, 0.f, 0.f, 0.f};
        int dbase[2]; unsigned vmask[2];
#pragma unroll
        for (int g = 0; g < 2; ++g) { const int qg = qg0 + g, c0w = (qg == 0) ? 0 : (qg == 1) ? 8 : (qg == 2) ? 24 : 32; const int qc = 16 * qg + fr, cs = min(max(qc - 8, 0), 48);
            dbase[g] = c0w + 8 * fq - qc + 15; vmask[g] = 0u;
#pragma unroll
            for (int i = 0; i < 8; ++i) { const int kc = c0w + 8 * fq + i; if (kc >= cs && kc < cs + 16) vmask[g] |= 1u << i; } }
#define NA_WRITE(buf_) do { LAS unsigned char* sn_ = stg + (buf_) * STG; \
            const float a0 = lo16(ska0.x), a1 = hi16(ska0.x), a2 = lo16(ska0.y), a3 = hi16(ska0.y), a4 = lo16(ska0.z), a5 = hi16(ska0.z), a6 = lo16(ska0.w), a7 = hi16(ska0.w); \
            const float c0 = lo16(ska1.x), c1 = hi16(ska1.x), c2 = lo16(ska1.y), c3 = hi16(ska1.y), c4 = lo16(ska1.z), c5 = hi16(ska1.z), c6 = lo16(ska1.w), c7 = hi16(ska1.w); \
            float ss_ = ((a0 * a0 + a1 * a1) + (a2 * a2 + a3 * a3)) + ((a4 * a4 + a5 * a5) + (a6 * a6 + a7 * a7)) + ((c0 * c0 + c1 * c1) + (c2 * c2 + c3 * c3)) + ((c4 * c4 + c5 * c5) + (c6 * c6 + c7 * c7)); \
            ss_ += __shfl_xor(ss_, 8); ss_ += __shfl_xor(ss_, 16); ss_ += __shfl_xor(ss_, 32); \
            const float ks_ = rsqrtf(ss_ * (1.f / 128.f) + EPS); v4u k0_, k1_; \
            k0_.x = pk2(a0 * ks_, a1 * ks_); k0_.y = pk2(a2 * ks_, a3 * ks_); k0_.z = pk2(a4 * ks_, a5 * ks_); k0_.w = pk2(a6 * ks_, a7 * ks_); \
            k1_.x = pk2(c0 * ks_, c1 * ks_); k1_.y = pk2(c2 * ks_, c3 * ks_); k1_.z = pk2(c4 * ks_, c5 * ks_); k1_.w = pk2(c6 * ks_, c7 * ks_); \
            *(LAS v4u*)(sn_ + (sc * 64 + kpos) * 16) = k0_; *(LAS v4u*)(sn_ + ((sc + 8) * 64 + kpos) * 16) = k1_; \
            *(LAS v4u*)(sn_ + KB + (sc * 128 + vpos0) * 16) = sva0; *(LAS v4u*)(sn_ + KB + (sc * 128 + vpos1) * 16) = sva1; } while (0)
#define NA_COMPUTE(st_) do { const int kr = klo + (st_); const LAS unsigned char* sb = stg + ((st_) & 1) * STG; \
            if (kr >= rs && kr <= rs + 7) { const int dr = kr - r + 7; \
                _Pragma("unroll") for (int g = 0; g < 2; ++g) { \
                    const int qg = qg0 + g, c0w = (qg == 0) ? 0 : (qg == 1) ? 8 : (qg == 2) ? 24 : 32; \
                    const int k1 = c0w + 8 * (fr >> 2) + (fr & 3), k2 = k1 + 4; \
                    const int p1 = k1 ^ (((k1 >> 4) & 1) << 2), p2 = k2 ^ (((k2 >> 4) & 1) << 2); \
                    f32x4 s1 = {0.f, 0.f, 0.f, 0.f}, s2 = {0.f, 0.f, 0.f, 0.f}; \
                    _Pragma("unroll") for (int ks = 0; ks < 4; ++ks) { const bf16x8 a1 = *(const LAS bf16x8*)(sb + ((4 * ks + fq) * 64 + p1) * 16), a2 = *(const LAS bf16x8*)(sb + ((4 * ks + fq) * 64 + p2) * 16); \
                        s1 = MFMA16(a1, Qf[g][ks], s1); s2 = MFMA16(a2, Qf[g][ks], s2); } \
                    float ps = 0.f; const LAS float* rpr = rpl + dr * 31 + dbase[g]; float bb[8]; \
                    _Pragma("unroll") for (int i = 0; i < 8; ++i) bb[i] = rpr[i]; \
                    _Pragma("unroll") for (int i = 0; i < 4; ++i) { \
                        const float x1 = __expf(s1[i] + bb[i]), x2 = __expf(s2[i] + bb[i + 4]); \
                        const float e1 = ((vmask[g] >> i) & 1u) ? x1 : 0.f, e2 = ((vmask[g] >> (i + 4)) & 1u) ? x2 : 0.f; \
                        s1[i] = e1; s2[i] = e2; ps += e1 + e2; } \
                    l[g] += ps; \
                    v4u pw; pw.x = pk2(s1[0], s1[1]); pw.y = pk2(s1[2], s1[3]); pw.z = pk2(s2[0], s2[1]); pw.w = pk2(s2[2], s2[3]); \
                    const bf16x8 Pf = __builtin_bit_cast(bf16x8, pw); \
                    const int vch = (c0w >> 3) + fq; \
                    _Pragma("unroll") for (int dt = 0; dt < 8; ++dt) { \
                        const bf16x8 av = *(const LAS bf16x8*)(sb + KB + (vch * 128 + dt * 16 + fr) * 16); O[g][dt] = MFMA16(av, Pf, O[g][dt]); } \
                } } } while (0)
        __syncthreads();
        NA_WRITE(0);
        __syncthreads();
#pragma unroll 1
        for (int st = 0; st < nst; ++st) {
            const bool more = (st + 1 < nst);
            if (more) NA_LOAD(klo + st + 1);
            NA_COMPUTE(st);
            if (more) NA_WRITE((st + 1) & 1);
            __syncthreads();
        }
#undef NA_LOAD
#undef NA_WRITE
#undef NA_COMPUTE
        { v2u bzr[2][8];
#pragma unroll
          for (int g = 0; g < 2; ++g) { const size_t qtok = (size_t)b * SEQ + r * 64 + 16 * (qg0 + g) + fr;
#pragma unroll
              for (int dt = 0; dt < 8; ++dt) bzr[g][dt] = *(const v2u*)(BZ + qtok * DM + h * BHD + dt * 16 + 4 * fq); }
          __builtin_amdgcn_sched_barrier(0);
#pragma unroll
          for (int g = 0; g < 2; ++g) { float ls = l[g]; ls += __shfl_xor(ls, 16); ls += __shfl_xor(ls, 32); const float inv = 1.f / ls;
            const size_t qtok = (size_t)b * SEQ + r * 64 + 16 * (qg0 + g) + fr;
#pragma unroll
            for (int dt = 0; dt < 8; ++dt) { const int ch = h * BHD + dt * 16 + 4 * fq; const v2u bz = bzr[g][dt];
                v2u o; o.x = pk2(O[g][dt][0] * inv * lo16(bz.x), O[g][dt][1] * inv * hi16(bz.x)); o.y = pk2(O[g][dt][2] * inv * lo16(bz.y), O[g][dt][3] * inv * hi16(bz.y));
                *(v2u*)(YC + qtok * 8192 + 4096 + ch) = o; } } }
    }
    __syncthreads();
}


constexpr int WS_HD_IS_BQK = 1;
__device__ __forceinline__ void mlstm_out_mfma(const Args& A, Frame& F) {
    const bf16* QC = (const bf16*)(A.ws + WS_QC); const bf16* VT = (const bf16*)(A.ws + WS_VT); const bf16* CT = (const bf16*)(A.ws + WS_CT);
    const float* NST = (const float*)(A.ws + WS_NST); const float* R1 = (const float*)(A.ws + WS_R1); const float* R2 = (const float*)(A.ws + WS_R2);
    bf16* HD = (bf16*)(A.ws + WS_BQK);
    LAS unsigned char* Ql = F.lds; LAS unsigned char* Kl = F.lds + 67584; LAS unsigned char* Sl = Kl;
    LAS float* r1l = (LAS float*)(F.lds + 135168); LAS float* r2l = r1l + 128; LAS float* qnl = r1l + 256; LAS float* dsl = r1l + 384;
    LAS float* nstl = r1l + 640;
    const int fr = F.lane & 15, fq = F.lane >> 4, wvv = F.tid >> 6;
    for (int u0 = F.bid; u0 < 2 * NBATCH * AH * NCHUNK; u0 += F.G) {
        int u = u0;
        if (F.G == 256) { const int i_ = u0 >> 8, x_ = u0 & 7, s_ = (u0 >> 3) & 31; u = ((i_ * 128 + x_ * 16 + (s_ >> 1)) << 1) | (s_ & 1); }
        const int dir = u & 1, j = (u >> 1) & 31, h = (u >> 6) & 7, b = u >> 9;
        const size_t m0 = (size_t)b * SEQ + j * 128; const size_t sidx = ((size_t)(dir * NBATCH + b) * AH + h) * NCHUNK + j;
        const bf16* KA = (const bf16*)(A.ws + (dir ? WS_KAB : WS_KAF));
        __syncthreads();
#pragma unroll
        for (int p = 0; p < 8; ++p) { const int e = p * NTHREADS + F.tid, row = e >> 5, ch = e & 31; const size_t go = (m0 + row) * AQKW + h * ADK + ch * 8;
            const v4u q = *(const v4u*)(QC + go), k = *(const v4u*)(KA + go);
            *(LAS v4u*)(Ql + row * 528 + ch * 16) = q; *(LAS v4u*)(Kl + row * 528 + ch * 16) = k; }
        if (F.tid < 128) { const size_t so = (size_t)(dir * NBATCH * AH + b * AH + h) * SEQ + j * 128 + F.tid; r1l[F.tid] = R1[so]; r2l[F.tid] = R2[so]; }
        else if (F.tid < 192) { const int e = F.tid - 128; *(LAS f32x4*)(nstl + 4 * e) = *(const f32x4*)(NST + sidx * ADK + 4 * e); }
        __syncthreads();
        const int vrow = wvv * 64 + 16 * (fr >> 2) + (fr & 3);
        const bf16* ctb = CT + (sidx * ADV + vrow) * ADK + 8 * fq;
        const bf16* vtb = VT + (size_t)(h * ADV + vrow) * MTOK + m0 + 8 * fq;
        bf16x8 bfr0[4];
#pragma unroll
        for (int vt = 0; vt < 4; ++vt) bfr0[vt] = *(const bf16x8*)(ctb + (size_t)(vt * 4) * ADK);
        { const int t = F.tid >> 2, part = F.tid & 3; const LAS float* nst = nstl + part * 64; float sacc_ = 0.f;
#pragma unroll
          for (int c = 0; c < 8; ++c) { const v4u w = *(const LAS v4u*)(Ql + t * 528 + part * 128 + c * 16); const f32x4 n0 = *(const LAS f32x4*)(nst + c * 8), n1 = *(const LAS f32x4*)(nst + c * 8 + 4);
              sacc_ += lo16(w.x) * n0[0] + hi16(w.x) * n0[1] + lo16(w.y) * n0[2] + hi16(w.y) * n0[3] + lo16(w.z) * n1[0] + hi16(w.z) * n1[1] + lo16(w.w) * n1[2] + hi16(w.w) * n1[3]; }
          sacc_ += __shfl_xor(sacc_, 1); sacc_ += __shfl_xor(sacc_, 2); if (part == 0) qnl[t] = sacc_; }
        f32x4 sacc[2][4];
        { const int tw = wvv >> 1, sw = wvv & 1;
#pragma unroll
          for (int a = 0; a < 2; ++a)
#pragma unroll
              for (int c = 0; c < 4; ++c) sacc[a][c] = (f32x4){0.f, 0.f, 0.f, 0.f};
#pragma unroll 2
          for (int ks = 0; ks < 8; ++ks) {
              bf16x8 qf[2], kf[4];
#pragma unroll
              for (int a = 0; a < 2; ++a) qf[a] = *(const LAS bf16x8*)(Ql + ((2 * tw + a) * 16 + fr) * 528 + (32 * ks + 8 * fq) * 2);
#pragma unroll
              for (int c = 0; c < 4; ++c) kf[c] = *(const LAS bf16x8*)(Kl + ((4 * sw + c) * 16 + fr) * 528 + (32 * ks + 8 * fq) * 2);
#pragma unroll
              for (int a = 0; a < 2; ++a)
#pragma unroll
                  for (int c = 0; c < 4; ++c) sacc[a][c] = MFMA16(kf[c], qf[a], sacc[a][c]);
          }
#pragma unroll
          for (int a = 0; a < 2; ++a) { const int t = (2 * tw + a) * 16 + fr; const float r2v = r2l[t]; float dsum = 0.f;
#pragma unroll
              for (int c = 0; c < 4; ++c)
#pragma unroll
                  for (int i = 0; i < 4; ++i) { const int sx = (4 * sw + c) * 16 + 4 * fq + i; const bool valid = dir ? (sx >= t) : (sx <= t); const float v = valid ? sacc[a][c][i] * r2v : 0.f; sacc[a][c][i] = v; dsum += v; }
              dsum += __shfl_xor(dsum, 16); dsum += __shfl_xor(dsum, 32);
              if (fq == 0) dsl[sw * 128 + t] = dsum; }
          __syncthreads();
#pragma unroll
          for (int a = 0; a < 2; ++a)
#pragma unroll
              for (int c = 0; c < 4; ++c) { v2u w; w.x = pk2(sacc[a][c][0], sacc[a][c][1]); w.y = pk2(sacc[a][c][2], sacc[a][c][3]);
                  *(LAS v2u*)(Sl + ((2 * tw + a) * 16 + fr) * 272 + ((4 * sw + c) * 16 + 4 * fq) * 2) = w; }
        }
        __syncthreads();
        bf16* hd = HD + (size_t)dir * MTOK * DM;
        {
            f32x4 acc[8][4];
#pragma unroll
            for (int tt = 0; tt < 8; ++tt)
#pragma unroll
                for (int vt = 0; vt < 4; ++vt) acc[tt][vt] = (f32x4){0.f, 0.f, 0.f, 0.f};
#define P5_STEP(B_, L_, RS_, ks_) do { _Pragma("unroll") for (int th = 0; th < 2; ++th) { bf16x8 af[4]; \
                _Pragma("unroll") for (int tt = 0; tt < 4; ++tt) af[tt] = *(const LAS bf16x8*)((L_) + ((th * 4 + tt) * 16 + fr) * (RS_) + (32 * (ks_) + 8 * fq) * 2); \
                _Pragma("unroll") for (int tt = 0; tt < 4; ++tt) _Pragma("unroll") for (int vt = 0; vt < 4; ++vt) acc[th * 4 + tt][vt] = MFMA16(B_[vt], af[tt], acc[th * 4 + tt][vt]); } } while (0)
            P5_STEP(bfr0, Ql, 528, 0);
#pragma unroll 1
            for (int ks = 1; ks < 8; ++ks) {
                bf16x8 bfr[4];
#pragma unroll
                for (int vt = 0; vt < 4; ++vt) bfr[vt] = *(const bf16x8*)(ctb + (size_t)(vt * 4) * ADK + 32 * ks);
                P5_STEP(bfr, Ql, 528, ks);
            }
#pragma unroll
            for (int tt = 0; tt < 8; ++tt) { const float r1v = r1l[tt * 16 + fr];
#pragma unroll
                for (int vt = 0; vt < 4; ++vt) acc[tt][vt] *= r1v; }
#pragma unroll 1
            for (int ks = 0; ks < 4; ++ks) {
                bf16x8 bfr[4];
#pragma unroll
                for (int vt = 0; vt < 4; ++vt) bfr[vt] = *(const bf16x8*)(vtb + (size_t)(vt * 4) * MTOK + 32 * ks);
                P5_STEP(bfr, Sl, 272, ks);
            }
#undef P5_STEP
#pragma unroll
            for (int tt = 0; tt < 8; ++tt) { const int t = tt * 16 + fr; const float den = r1l[t] * qnl[t] + dsl[t] + dsl[128 + t]; const float inv = 1.f / fmaxf(fabsf(den), 1.0f);
                bf16* hp = hd + (m0 + t) * DM + h * ADV + wvv * 64 + 16 * fq;
                v4u w0, w1;
                w0.x = pk2(acc[tt][0][0] * inv, acc[tt][0][1] * inv); w0.y = pk2(acc[tt][0][2] * inv, acc[tt][0][3] * inv); w0.z = pk2(acc[tt][1][0] * inv, acc[tt][1][1] * inv); w0.w = pk2(acc[tt][1][2] * inv, acc[tt][1][3] * inv);
                w1.x = pk2(acc[tt][2][0] * inv, acc[tt][2][1] * inv); w1.y = pk2(acc[tt][2][2] * inv, acc[tt][2][3] * inv); w1.z = pk2(acc[tt][3][0] * inv, acc[tt][3][1] * inv); w1.w = pk2(acc[tt][3][2] * inv, acc[tt][3][3] * inv);
                *(v4u*)hp = w0; *(v4u*)(hp + 8) = w1; }
        }
    }
    __syncthreads();
}
__device__ __forceinline__ void mlstm_combine(const Args& A, Frame& F) {
    const bf16* HD0 = (const bf16*)(A.ws + WS_BQK); const bf16* HD1 = HD0 + (size_t)MTOK * DM; const bf16* GA = (const bf16*)(A.ws + WS_GA); bf16* YC = (bf16*)(A.ws + WS_YCAT);
    const int gw = F.bid * NWAVES + F.wave, NGW = F.G * NWAVES;
    const int h = gw & 7;
    const f32x4 g0 = *(const f32x4*)(A.in[8] + h * ADV + F.lane * 8), g1 = *(const f32x4*)(A.in[8] + h * ADV + F.lane * 8 + 4);
    v4u a0[4], c0[4], q0[4], a1[4], c1[4], q1[4];
#define MC_LOAD(a_, c_, q_, it_) do { _Pragma("unroll") for (int k = 0; k < 4; ++k) { const int i_ = (it_) + k * NGW; if (i_ < MTOK * AH) { const size_t off = (size_t)(i_ >> 3) * DM + h * ADV + F.lane * 8; \
            a_[k] = *(const v4u*)(HD0 + off); c_[k] = *(const v4u*)(HD1 + off); q_[k] = *(const v4u*)(GA + off); } } } while (0)
#define MC_PROC(a_, c_, q_, it_) do { _Pragma("unroll") for (int k = 0; k < 4; ++k) { const int i_ = (it_) + k * NGW; if (i_ < MTOK * AH) { const v4u a = a_[k], c = c_[k], g = q_[k]; \
            float x[8] = {lo16(a.x) + lo16(c.x), hi16(a.x) + hi16(c.x), lo16(a.y) + lo16(c.y), hi16(a.y) + hi16(c.y), lo16(a.z) + lo16(c.z), hi16(a.z) + hi16(c.z), lo16(a.w) + lo16(c.w), hi16(a.w) + hi16(c.w)}; \
            float ss = 0.f; _Pragma("unroll") for (int i = 0; i < 8; ++i) ss += x[i] * x[i]; \
            const float rstd = rsqrtf(wave_sum(ss) * (1.f / ADV) + EPS); \
            v4u o; o.x = pk2(x[0] * rstd * g0[0] * lo16(g.x), x[1] * rstd * g0[1] * hi16(g.x)); o.y = pk2(x[2] * rstd * g0[2] * lo16(g.y), x[3] * rstd * g0[3] * hi16(g.y)); \
            o.z = pk2(x[4] * rstd * g1[0] * lo16(g.z), x[5] * rstd * g1[1] * hi16(g.z)); o.w = pk2(x[6] * rstd * g1[2] * lo16(g.w), x[7] * rstd * g1[3] * hi16(g.w)); \
            *(v4u*)(YC + (size_t)(i_ >> 3) * 8192 + h * ADV + F.lane * 8) = o; } } } while (0)
    MC_LOAD(a0, c0, q0, gw);
#pragma unroll 1
    for (int it = gw; it < MTOK * AH; it += 8 * NGW) {
        MC_LOAD(a1, c1, q1, it + 4 * NGW); __builtin_amdgcn_sched_barrier(0);
        MC_PROC(a0, c0, q0, it); __builtin_amdgcn_sched_barrier(0);
        MC_LOAD(a0, c0, q0, it + 8 * NGW); __builtin_amdgcn_sched_barrier(0);
        MC_PROC(a1, c1, q1, it + 4 * NGW); __builtin_amdgcn_sched_barrier(0);
    }
#undef MC_LOAD
#undef MC_PROC
}


__device__ __forceinline__ void sgu_mfma(const Args& A, Frame& F) {
    const bf16* GVT = (const bf16*)(A.ws + WS_GVT); const bf16* UZ = (const bf16*)(A.ws + WS_UZ); const float* VSS = (const float*)(A.ws + WS_VSS);
    bf16* Y1 = (bf16*)(A.ws + WS_Y1);
    LAS unsigned char* Wl = F.lds;
    LAS float* rs = (LAS float*)(F.lds + 32768);
    LAS float* rp = rs + 128;
    const int fr = F.lane & 15, fq = F.lane >> 4, wvv = F.tid >> 6;
    const float* cws = A.in[18]; const float* cbs = A.in[19]; const float* cg = A.in[17];
    for (int u = F.bid; u < NBATCH * NCHUNK * 2; u += F.G) {
        const int b = u >> 6, n = (u >> 1) & 31, gh = u & 1; const size_t m0 = (size_t)b * SEQ + n * 128;
        __syncthreads();
        { const int s = F.tid & 127, part = F.tid >> 7; float a = 0.f;
#pragma unroll
          for (int p = 0; p < 16; ++p) a += VSS[(size_t)(part * 16 + p) * MTOK + m0 + s];
          rp[part * 128 + s] = a; }
        __syncthreads();
        if (F.tid < 128) rs[F.tid] = rsqrtf((rp[F.tid] + rp[128 + F.tid] + rp[256 + F.tid] + rp[384 + F.tid]) * (1.f / CWID) + EPS);
#pragma unroll 1
        for (int gi = 0; gi < 4; ++gi) {
            const int g = gh * 4 + gi;
            __syncthreads();
#pragma unroll
            for (int it = 0; it < 4; ++it) { const int idx = it * NTHREADS + F.tid, t = idx & 127, c = idx >> 7; const float* wp = cws + (size_t)g * 16384 + t * 128 + c * 8;
                const f32x4 w0 = *(const f32x4*)wp, w1 = *(const f32x4*)(wp + 4); const f32x4 r0 = *(const LAS f32x4*)(rs + c * 8), r1 = *(const LAS f32x4*)(rs + c * 8 + 4);
                v4u o; o.x = pk2(w0[0] * r0[0], w0[1] * r0[1]); o.y = pk2(w0[2] * r0[2], w0[3] * r0[3]); o.z = pk2(w1[0] * r1[0], w1[1] * r1[1]); o.w = pk2(w1[2] * r1[2], w1[3] * r1[3]);
                *(LAS v4u*)(Wl + (c * 128 + t) * 16) = o; }
            __syncthreads();
#pragma unroll 1
            for (int q = 0; q < 2; ++q) {
                const int ch0 = g * CGC + (wvv * 2 + q) * 64;
                const bf16* ap = GVT + (size_t)(ch0 + 16 * (fr >> 2) + (fr & 3)) * MTOK + m0 + 8 * fq;
                bf16x8 Af[4][4];
#pragma unroll
                for (int ct = 0; ct < 4; ++ct)
#pragma unroll
                    for (int ks = 0; ks < 4; ++ks) Af[ct][ks] = *(const bf16x8*)(ap + (size_t)(4 * ct) * MTOK + 32 * ks);
                const int chb = ch0 + 16 * fq;
                f32x4 gn[4];
#pragma unroll
                for (int ct = 0; ct < 4; ++ct) gn[ct] = *(const f32x4*)(cg + chb + 4 * ct);
                v4u uzr[8][2]; float bsr[8];
#pragma unroll
                for (int tt = 0; tt < 8; ++tt) { const size_t off = (m0 + tt * 16 + fr) * CWID + chb; uzr[tt][0] = *(const v4u*)(UZ + off); uzr[tt][1] = *(const v4u*)(UZ + off + 8); bsr[tt] = cbs[g * 128 + tt * 16 + fr]; }
                __builtin_amdgcn_sched_barrier(0);
#pragma unroll
                for (int tt = 0; tt < 8; ++tt) {
                    const int t = tt * 16 + fr; const size_t off = (m0 + t) * CWID + chb;
                    const v4u uz0 = uzr[tt][0], uz1 = uzr[tt][1];
                    const float bias = bsr[tt];
                    bf16x8 Bf[4];
#pragma unroll
                    for (int ks = 0; ks < 4; ++ks) Bf[ks] = *(const LAS bf16x8*)(Wl + ((4 * ks + fq) * 128 + t) * 16);
                    f32x4 acc[4];
#pragma unroll
                    for (int ct = 0; ct < 4; ++ct) { acc[ct] = (f32x4){0.f, 0.f, 0.f, 0.f};
#pragma unroll
                        for (int ks = 0; ks < 4; ++ks) acc[ct] = MFMA16(Af[ct][ks], Bf[ks], acc[ct]); }
                    const unsigned uw[8] = {uz0.x, uz0.y, uz0.z, uz0.w, uz1.x, uz1.y, uz1.z, uz1.w};
                    unsigned ow[8];
#pragma unroll
                    for (int ct = 0; ct < 4; ++ct) {
                        ow[2 * ct] = pk2(lo16(uw[2 * ct]) * (gn[ct][0] * acc[ct][0] + bias), hi16(uw[2 * ct]) * (gn[ct][1] * acc[ct][1] + bias));
                        ow[2 * ct + 1] = pk2(lo16(uw[2 * ct + 1]) * (gn[ct][2] * acc[ct][2] + bias), hi16(uw[2 * ct + 1]) * (gn[ct][3] * acc[ct][3] + bias)); }
                    v4u o0, o1; o0.x = ow[0]; o0.y = ow[1]; o0.z = ow[2]; o0.w = ow[3]; o1.x = ow[4]; o1.y = ow[5]; o1.z = ow[6]; o1.w = ow[7];
                    *(v4u*)(Y1 + off) = o0; *(v4u*)(Y1 + off + 8) = o1;
                }
            }
        }
    }
    __syncthreads();
}

__global__ void __launch_bounds__(NTHREADS, 2) mk_fwd(Args A) {
    extern __shared__ __attribute__((aligned(16))) unsigned char lds[];
    Frame F;
    F.lds = (LAS unsigned char*)lds; F.tid = threadIdx.x; F.lane = F.tid & 63; F.wave = __builtin_amdgcn_readfirstlane(F.tid >> 6); F.G = gridDim.x; F.bid = blockIdx.x;
    volatile LAS unsigned* MISC = (volatile LAS unsigned*)(F.lds + MISC_OFF);
    if (F.tid < 64) MISC[F.tid] = 0u;
    __syncthreads();
    XcdBarrier bar; bar.bar = (unsigned*)(A.ws + WS_CTL) + CW_BAR; bar.x = 0; bar.st = nullptr;
    if (N_LAUNCHES == 1) bar = xcd_barrier_post((unsigned*)(A.ws + WS_CTL) + CW_BAR, MISC + 8);
    const int lo = A.ph_lo, hi = A.ph_hi;
#define IN(k) (lo <= (k) && (k) < hi)
#define SEAM(k) do { if (IN(k) && IN((k) + 1)) xcd_barrier(bar); } while (0)
#ifndef DBL_MASK
#define DBL_MASK 0u
#endif
#define REP(k) _Pragma("unroll") for (int rep_ = 0; rep_ <= (int)((DBL_MASK >> (k)) & 1u); ++rep_)
#define REPB() do { if (rep_) xcd_barrier(bar); } while (0)
    float* mod0 = (float*)(A.ws + WS_MOD); float* mod1 = mod0 + 4 * 12288;
    bf16* H = (bf16*)(A.ws + WS_H);
    LAS unsigned char* ring = F.lds;

    if (IN(0)) { REP(16) { ada_items(A, F, rep_); } REP(14) { REPB(); p0_prep(A, F); } } SEAM(0);
    if ((DBL_MASK >> 18) & 1u) { for (int xb_ = 0; xb_ < 20; ++xb_) xcd_barrier(bar); }
    if (IN(1)) REP(1) { REPB(); norm_rows<false>(A, F, A.in[0], A.in[2], mod0, A.in[4], H); } SEAM(1);
    if (IN(2)) REP(2) { REPB();
        gates_mfma(A, F);
        const bf16* W0A = (const bf16*)(A.ws + WS_W0A);
        { pg8::Gemm g{H, W0A, MTOK, 4096, DM}; pg8::StaticOrder S; S.init(MTOK, 4096, F.G, F.bid); pg8::EpiStore<0> E{(bf16*)(A.ws + WS_QKRAW), DM};
          pg8::gemm_phase<pg8::EpiStore<0>, pg8::StaticOrder, true, true>(ring, g, S, E); }
        { pg8::Gemm g{H, W0A + (size_t)4096 * DM, MTOK, 8192, DM}; pg8::StaticOrder S; S.init(MTOK, 8192, F.G, F.bid); pg8::EpiPair<0> E{(bf16*)(A.ws + WS_GA), DM};
          pg8::gemm_phase<pg8::EpiPair<0>, pg8::StaticOrder, true, true>(ring, g, S, E); }
        { pg8::Gemm g{H, W0A + (size_t)12288 * DM, MTOK, 8192, DM}; pg8::StaticOrder S; S.init(MTOK, 8192, F.G, F.bid); pg8::EpiStore<0> E{(bf16*)(A.ws + WS_BQK), 8192};
          pg8::gemm_phase<pg8::EpiStore<0>, pg8::StaticOrder, true, true>(ring, g, S, E); }
        { pg8::Gemm g{H, W0A + (size_t)20480 * DM, MTOK, 4096, DM}; pg8::StaticOrder S; S.init(MTOK, 4096, F.G, F.bid); pg8::EpiStore<1> E{(bf16*)(A.ws + WS_BZ), DM};
          pg8::gemm_phase<pg8::EpiStore<1>, pg8::StaticOrder, true, true>(ring, g, S, E); }
        { pg8::Gemm g{(const bf16*)(A.ws + WS_W0V), H, 8192, MTOK, DM}; pg8::HybridOrder S; S.init(8192, MTOK, F.G, F.bid); S.ns = 5; S.head = (unsigned*)(A.ws + WS_CTL) + CW_QUEUE + 0 * 64; S.slot = (volatile LAS int*)(MISC + 16); pg8::EpiStore<0> E{(bf16*)(A.ws + WS_VT), MTOK};
          pg8::gemm_phase<pg8::EpiStore<0>, pg8::HybridOrder, true, true>(ring, g, S, E); }
    } SEAM(2);
    if (IN(3)) { REP(15) { REPB(); mid_opt(A, F); } }     SEAM(3);
    if (IN(4)) { REP(12) { REPB(); scan_mfma(A, F); } REP(13) { REPB(); natten_lds(A, F); } } SEAM(4);
    if (IN(5)) REP(5) { REPB(); mlstm_out_mfma(A, F); } SEAM(5);
    if (IN(6)) REP(6) { REPB(); mlstm_combine(A, F); } SEAM(6);
    if (IN(7)) REP(7) { REPB();
        pg8::Gemm g{(const bf16*)(A.ws + WS_YCAT), (const bf16*)(A.ws + WS_WOUT0), MTOK, DM, 8192}; pg8::StaticOrder S; S.init(MTOK, DM, F.G, F.bid);
        pg8::EpiResid<false, true> E{A.in[0], (void*)(A.ws + WS_X1), DM, mod0, A.in[4], SEQ};
        pg8::gemm_phase<pg8::EpiResid<false, true>, pg8::StaticOrder, true, true>(ring, g, S, E);
        p7_prep1(A, F);
    } SEAM(7);
    if (IN(8)) REP(8) { REPB(); norm_rows<true>(A, F, (const void*)(A.ws + WS_X1), A.in[13], mod1, A.in[15], H); } SEAM(8);
    if (IN(9)) REP(9) { REPB();
#ifdef PROBE_CU192
        const int r192 = F.bid >> 3; const bool act192 = (r192 & 3) != 3; const int c192 = (r192 - (r192 >> 2)) * 8 + (F.bid & 7);
        if (act192) {
        { pg8::Gemm g{H, (const bf16*)(A.ws + WS_W1A), MTOK, 16384, DM}; pg8::StaticOrder S; S.init(MTOK, 16384, 192, c192); pg8::EpiPair<1> E{(bf16*)(A.ws + WS_UZ), CWID};
          pg8::gemm_phase<pg8::EpiPair<1>, pg8::StaticOrder, true, true>(ring, g, S, E); }
        { pg8::Gemm g{(const bf16*)(A.ws + WS_W1V), H, 8192, MTOK, DM}; pg8::StaticOrder S; S.init(8192, MTOK, 192, c192); pg8::EpiGeluT E{(bf16*)(A.ws + WS_GVT), MTOK, (float*)(A.ws + WS_VSS), MTOK};
          pg8::gemm_phase<pg8::EpiGeluT, pg8::StaticOrder, true, true>(ring, g, S, E); }
        }
        if (false) {
#else
        {
#endif
        { pg8::Gemm g{H, (const bf16*)(A.ws + WS_W1A), MTOK, 16384, DM}; pg8::StaticOrder S; S.init(MTOK, 16384, F.G, F.bid); pg8::EpiPair<1> E{(bf16*)(A.ws + WS_UZ), CWID};
          pg8::gemm_phase<pg8::EpiPair<1>, pg8::StaticOrder, true, true>(ring, g, S, E); }
        { pg8::Gemm g{(const bf16*)(A.ws + WS_W1V), H, 8192, MTOK, DM}; pg8::HybridOrder S; S.init(8192, MTOK, F.G, F.bid); S.ns = 5; S.head = (unsigned*)(A.ws + WS_CTL) + CW_QUEUE + 1 * 64; S.slot = (volatile LAS int*)(MISC + 16); pg8::EpiGeluT E{(bf16*)(A.ws + WS_GVT), MTOK, (float*)(A.ws + WS_VSS), MTOK};
          pg8::gemm_phase<pg8::EpiGeluT, pg8::HybridOrder, true, true>(ring, g, S, E); }
        }
    } SEAM(9);
    if (IN(10)) REP(10) { REPB(); sgu_mfma(A, F); } SEAM(10);
    if (IN(11)) REP(11) { REPB();
        pg8::Gemm g{(const bf16*)(A.ws + WS_Y1), (const bf16*)(A.ws + WS_WOUT1), MTOK, DM, 8192}; pg8::StaticOrder S; S.init(MTOK, DM, F.G, F.bid);
        pg8::EpiResid<true, false> E{(const void*)(A.ws + WS_X1), (void*)A.out, DM, mod1, A.in[15], SEQ};
        pg8::gemm_phase<pg8::EpiResid<true, false>, pg8::StaticOrder, true, true>(ring, g, S, E);
    }
#undef IN
#undef SEAM
}

extern "C" void kernel_launch(void* const* d_in, const int* in_sizes, int n_in, void* d_out, int out_size, void* d_ws, size_t ws_size, hipStream_t stream) {
    static int grid = 0;
    if (grid == 0) {
        if (n_in != 21 || out_size != MTOK * DM || ws_size < WS_NEED) { fprintf(stderr, "kernel_launch: unexpected shapes (n_in %d, out %d, ws %zu, need %zu); nothing launched\n", n_in, out_size, ws_size, (size_t)WS_NEED); grid = -1; return; }
        int dev = 0, cus = 0, per_cu = 0;
        if (hipGetDevice(&dev) != hipSuccess || hipDeviceGetAttribute(&cus, hipDeviceAttributeMultiprocessorCount, dev) != hipSuccess) { grid = -1; return; }
        if (hipFuncSetAttribute((const void*)mk_fwd, hipFuncAttributeMaxDynamicSharedMemorySize, LDS_BYTES) != hipSuccess) { fprintf(stderr, "kernel_launch: hipFuncSetAttribute failed\n"); grid = -1; return; }
        if (hipOccupancyMaxActiveBlocksPerMultiprocessor(&per_cu, (const void*)mk_fwd, NTHREADS, LDS_BYTES) != hipSuccess || per_cu < 1) { fprintf(stderr, "kernel_launch: occupancy query says %d\n", per_cu); }
        (void)hipGetLastError();
        grid = cus;
    }
    if (grid < 0) return;
    if (hipMemsetAsync((char*)d_ws + WS_CTL, 0, CTL_ZERO_BYTES, stream) != hipSuccess) return;
    Args a{};
    for (int i = 0; i < 21; ++i) a.in[i] = (const float*)d_in[i];
    a.out = (float*)d_out; a.ws = (unsigned char*)d_ws;
    for (int li = 0; li < N_LAUNCHES; ++li) {
        a.ph_lo = (N_LAUNCHES == 1) ? 0 : li; a.ph_hi = (N_LAUNCHES == 1) ? NPHASE : li + 1;
        hipLaunchKernelGGL(mk_fwd, dim3(grid), dim3(NTHREADS), LDS_BYTES, stream, a);
        if (hipPeekAtLastError() != hipSuccess) { fprintf(stderr, "kernel_launch: launch %d failed\n", li); break; }
    }
}
```

```cpp
#include <hip/hip_runtime.h>
#include <cstdio>
#include <cstdint>
#include <type_traits>
#define LAS __attribute__((address_space(3)))
namespace pg8 {
#define PG8_LAS __attribute__((address_space(3)))
typedef unsigned short bf16_t;
typedef short bf16x8 __attribute__((ext_vector_type(8)));
typedef float f32x4 __attribute__((ext_vector_type(4)));
typedef unsigned u32x4 __attribute__((ext_vector_type(4)));
constexpr int BM = 256, BK = 64, HALF = 128, HTB = HALF * BK * 2  , STAGE_BYTES = 8 * HTB, NXCD = 8, WGM = 8;

__host__ __device__ __forceinline__ int lds_byte(int r, int c) { const int st = (r >> 4) * 2 + (c >> 5), rr = r & 15, cc = c & 31, ob = rr * 64 + cc * 2; return st * 1024 + (ob ^ (((ob >> 9) & 1) << 5)); }
__host__ __device__ __forceinline__ void stage_rc(int b, int& R, int& C) { const int st = b / 1024, sb = b % 1024, swz = sb ^ (((sb >> 9) & 1) << 5); R = (st >> 1) * 16 + swz / 64; C = (st & 1) * 32 + (swz % 64) / 2; }
__host__ __device__ __forceinline__ int perm32(int rho) { const int n = rho >> 4, i = rho & 15; return 8 * (i >> 2) + 4 * n + (i & 3); }

struct Unit { int pm, pn; };
struct Gemm { const bf16_t* A; const bf16_t* Bt; int M, N, K; };

struct StaticOrder {
    int nM, nN, nwg, G, c;
    __host__ __device__ void init(int M, int N, int G_, int c_) { nM = M / BM; nN = N / BM; nwg = nM * nN; G = G_; c = c_; }
    __host__ __device__ bool next(int i, Unit& u) const {
        const long L = (long)i * G + c; if (L >= nwg) return false;
        int wgid = (int)L; { const int q = nwg / NXCD, r = nwg % NXCD, xcd = wgid % NXCD, off = wgid / NXCD; wgid = (xcd < r ? xcd * (q + 1) : r * (q + 1) + (xcd - r) * q) + off; }
        const int nig = WGM * nN, gid = wgid / nig, fm = gid * WGM, gsz = (nM - fm) < WGM ? (nM - fm) : WGM;
        u.pm = fm + ((wgid % nig) % gsz); u.pn = (wgid % nig) / gsz; return true;
    }
    __device__ __forceinline__ void a_ready(const Unit&) const {}
    __device__ __forceinline__ void done(const Unit&) const {}
};
struct HybridOrder : StaticOrder {
    int ns; unsigned* head; volatile PG8_LAS int* slot;
    __device__ __forceinline__ bool next(int i, Unit& u) const {
        if (i < ns) return StaticOrder::next(i, u);
        if (threadIdx.x == 0) { const unsigned t = __hip_atomic_fetch_add(head, 1u, __ATOMIC_RELAXED, __HIP_MEMORY_SCOPE_AGENT); slot[i & 1] = (int)t; }
        asm volatile("s_waitcnt lgkmcnt(0)" ::: "memory"); __builtin_amdgcn_s_barrier(); asm volatile("" ::: "memory");
        const long L = (long)ns * G + slot[i & 1]; if (L >= nwg) return false;
        int wgid = (int)L; { const int q = nwg / NXCD, r = nwg % NXCD, xcd = wgid % NXCD, off = wgid / NXCD; wgid = (xcd < r ? xcd * (q + 1) : r * (q + 1) + (xcd - r) * q) + off; }
        const int nig = WGM * nN, gid = wgid / nig, fm = gid * WGM, gsz = (nM - fm) < WGM ? (nM - fm) : WGM;
        u.pm = fm + ((wgid % nig) % gsz); u.pn = (wgid % nig) / gsz; return true;
    }
};
__device__ __forceinline__ unsigned cvt_pk_bf16(float lo, float hi) { unsigned r; asm volatile("v_cvt_pk_bf16_f32 %0, %1, %2" : "=v"(r) : "v"(lo), "v"(hi)); return r; }
typedef float f32x2 __attribute__((ext_vector_type(2)));
__device__ __forceinline__ float act_sigm(float x) { return __builtin_amdgcn_rcpf(1.0f + __builtin_amdgcn_exp2f(-1.4426950408889634f * x)); }
__device__ __forceinline__ float act_silu(float x) { return x * act_sigm(x); }
__device__ __forceinline__ float act_gelu(float x) { const float y = x * (2.3022081985f + 0.1029432367f * x * x); return x * __builtin_amdgcn_rcpf(1.0f + __builtin_amdgcn_exp2f(-y)); }
template <int ACT> struct EpiStore {
    static constexpr bool PERM = true, AFTER_DRAIN = false;
    bf16_t* O; int ldc;
    __device__ __forceinline__ void operator()(const f32x4 (&acc)[2][2][4][2], const Unit& u, int wr, int wc, int fr, int fq) const {
        const int row0 = u.pm * BM + wr * 64 + fr, col0 = u.pn * BM + wc * 32 + 8 * fq;
#pragma unroll
        for (int ai = 0; ai < 2; ++ai)
#pragma unroll
            for (int m = 0; m < 4; ++m) { bf16_t* rowp = O + (size_t)(row0 + ai * HALF + m * 16) * ldc + col0;
#pragma unroll
                for (int bj = 0; bj < 2; ++bj) { f32x4 v0 = acc[ai][bj][m][0], v1 = acc[ai][bj][m][1];
                    if (ACT == 1) {
#pragma unroll
                        for (int j = 0; j < 4; ++j) { v0[j] = act_silu(v0[j]); v1[j] = act_silu(v1[j]); } }
                    if (ACT == 2) {
#pragma unroll
                        for (int j = 0; j < 4; ++j) { v0[j] = act_gelu(v0[j]); v1[j] = act_gelu(v1[j]); } }
                    u32x4 w; w.x = cvt_pk_bf16(v0[0], v0[1]); w.y = cvt_pk_bf16(v0[2], v0[3]); w.z = cvt_pk_bf16(v1[0], v1[1]); w.w = cvt_pk_bf16(v1[2], v1[3]);
                    *(u32x4*)(rowp + bj * HALF) = w; } }
    }
};
template <int KIND> struct EpiPair {
    static constexpr bool PERM = true, AFTER_DRAIN = false;
    bf16_t* O; int ldc;
    __device__ __forceinline__ void operator()(const f32x4 (&acc)[2][2][4][2], const Unit& u, int wr, int wc, int fr, int fq) const {
        const int row0 = u.pm * BM + wr * 64 + fr, col0 = u.pn * HALF + wc * 32 + 8 * fq;
#pragma unroll
        for (int ai = 0; ai < 2; ++ai)
#pragma unroll
            for (int m = 0; m < 4; ++m) { bf16_t* rowp = O + (size_t)(row0 + ai * HALF + m * 16) * ldc + col0;
                f32x4 r0, r1;
#pragma unroll
                for (int j = 0; j < 4; ++j) {
                    const float p0 = acc[ai][0][m][0][j], p1 = acc[ai][0][m][1][j], z0 = acc[ai][1][m][0][j], z1 = acc[ai][1][m][1][j];
                    r0[j] = (KIND == 0 ? act_sigm(p0) : act_gelu(p0)) * act_silu(z0);
                    r1[j] = (KIND == 0 ? act_sigm(p1) : act_gelu(p1)) * act_silu(z1); }
                u32x4 w; w.x = cvt_pk_bf16(r0[0], r0[1]); w.y = cvt_pk_bf16(r0[2], r0[3]); w.z = cvt_pk_bf16(r1[0], r1[1]); w.w = cvt_pk_bf16(r1[2], r1[3]);
                *(u32x4*)rowp = w; }
    }
};
struct EpiGeluT {
    static constexpr bool PERM = true, AFTER_DRAIN = false;
    bf16_t* O; int ldc; float* SS; int ldss;
    __device__ __forceinline__ void operator()(const f32x4 (&acc)[2][2][4][2], const Unit& u, int wr, int wc, int fr, int fq) const {
        const int row0 = u.pm * BM + wr * 64 + fr, col0 = u.pn * BM + wc * 32 + 8 * fq;
        f32x4 ss[2][2];
#pragma unroll
        for (int bj = 0; bj < 2; ++bj) { ss[bj][0] = (f32x4){0.f, 0.f, 0.f, 0.f}; ss[bj][1] = (f32x4){0.f, 0.f, 0.f, 0.f}; }
#pragma unroll
        for (int ai = 0; ai < 2; ++ai)
#pragma unroll
            for (int m = 0; m < 4; ++m) { bf16_t* rowp = O + (size_t)(row0 + ai * HALF + m * 16) * ldc + col0;
#pragma unroll
                for (int bj = 0; bj < 2; ++bj) { f32x4 v0 = acc[ai][bj][m][0], v1 = acc[ai][bj][m][1];
#pragma unroll
                    for (int j = 0; j < 4; ++j) { v0[j] = act_gelu(v0[j]); v1[j] = act_gelu(v1[j]); }
                    ss[bj][0] += v0 * v0; ss[bj][1] += v1 * v1;
                    u32x4 w; w.x = cvt_pk_bf16(v0[0], v0[1]); w.y = cvt_pk_bf16(v0[2], v0[3]); w.z = cvt_pk_bf16(v1[0], v1[1]); w.w = cvt_pk_bf16(v1[2], v1[3]);
                    *(u32x4*)(rowp + bj * HALF) = w; } }
#pragma unroll
        for (int bj = 0; bj < 2; ++bj)
#pragma unroll
            for (int n = 0; n < 2; ++n)
#pragma unroll
                for (int j = 0; j < 4; ++j) { float s = ss[bj][n][j]; s += __shfl_xor(s, 1); s += __shfl_xor(s, 2); s += __shfl_xor(s, 4); s += __shfl_xor(s, 8); ss[bj][n][j] = s; }
        if (fr == 0) { float* sp = SS + (size_t)(2 * u.pm + wr) * ldss + col0;
#pragma unroll
            for (int bj = 0; bj < 2; ++bj) { *(f32x4*)(sp + bj * HALF) = ss[bj][0]; *(f32x4*)(sp + bj * HALF + 4) = ss[bj][1]; } }
    }
};
template <bool BASE_BF16, bool OUT_BF16> struct EpiResid {
    static constexpr bool PERM = false, AFTER_DRAIN = false;
    const void* base; void* out; int ldc; const float* mod; const float* adab; int rows_per_batch;
    __device__ __forceinline__ void operator()(const f32x4 (&acc)[2][2][4][2], const Unit& u, int wr, int wc, int fr, int fq) const {
        const int row0 = u.pm * BM + wr * 64 + fr, col0 = u.pn * BM + wc * 32 + 4 * fq;
        const int b = (u.pm * BM) / rows_per_batch;
        typedef unsigned u32x2 __attribute__((ext_vector_type(2)));
        f32x4 gv[2][2];
#pragma unroll
        for (int bj = 0; bj < 2; ++bj)
#pragma unroll
            for (int n = 0; n < 2; ++n) gv[bj][n] = *(const f32x4*)(mod + (size_t)b * 3 * ldc + 2 * ldc + col0 + bj * HALF + n * 16) + *(const f32x4*)(adab + 2 * ldc + col0 + bj * HALF + n * 16);
        typedef typename std::conditional<BASE_BF16, u32x2, f32x4>::type bv_t;
        bv_t bA[2][2], bB[2][2];
#define ER_LOAD(B_, k_) do { const size_t off_ = (size_t)(row0 + ((k_) >> 2) * HALF + ((k_) & 3) * 16) * ldc + col0; \
            _Pragma("unroll") for (int bj = 0; bj < 2; ++bj) _Pragma("unroll") for (int n = 0; n < 2; ++n) { const size_t o = off_ + bj * HALF + n * 16; \
                if constexpr (BASE_BF16) B_[bj][n] = *(const bv_t*)((const bf16_t*)base + o); else B_[bj][n] = *(const bv_t*)((const float*)base + o); } \
            __builtin_amdgcn_sched_barrier(0); } while (0)
#define ER_STORE(B_, k_) do { const size_t off_ = (size_t)(row0 + ((k_) >> 2) * HALF + ((k_) & 3) * 16) * ldc + col0; \
            _Pragma("unroll") for (int bj = 0; bj < 2; ++bj) _Pragma("unroll") for (int n = 0; n < 2; ++n) { const size_t o = off_ + bj * HALF + n * 16; f32x4 bs; \
                if constexpr (BASE_BF16) { const u32x2 w = B_[bj][n]; bs = (f32x4){__uint_as_float(w.x << 16), __uint_as_float(w.x & 0xffff0000u), __uint_as_float(w.y << 16), __uint_as_float(w.y & 0xffff0000u)}; } \
                else bs = B_[bj][n]; \
                const f32x4 r = bs + gv[bj][n] * acc[(k_) >> 2][bj][(k_) & 3][n]; \
                if (OUT_BF16) { u32x2 w; w.x = cvt_pk_bf16(r[0], r[1]); w.y = cvt_pk_bf16(r[2], r[3]); *(u32x2*)((bf16_t*)out + o) = w; } \
                else *(f32x4*)((float*)out + o) = r; } \
            __builtin_amdgcn_sched_barrier(0); } while (0)
        ER_LOAD(bA, 0);
        ER_LOAD(bB, 1); ER_STORE(bA, 0);
        ER_LOAD(bA, 2); ER_STORE(bB, 1);
        ER_LOAD(bB, 3); ER_STORE(bA, 2);
        ER_LOAD(bA, 4); ER_STORE(bB, 3);
        ER_LOAD(bB, 5); ER_STORE(bA, 4);
        ER_LOAD(bA, 6); ER_STORE(bB, 5);
        ER_LOAD(bB, 7); ER_STORE(bA, 6);
        ER_STORE(bB, 7);
#undef ER_LOAD
#undef ER_STORE
    }
};

template <class Epi, class Sched, bool ALIGN_EPI = false, bool SP2 = false>
__device__ __forceinline__ void gemm_phase(PG8_LAS unsigned char* lds, const Gemm g, const Sched& S, const Epi& E) {
    const int tid = threadIdx.x, wid = __builtin_amdgcn_readfirstlane(tid >> 6), lane = tid & 63, wr = wid >> 2, wc = wid & 3, fr = lane & 15, fq = lane >> 4;
    const int K = g.K, nt = K / BK;
    unsigned voffA[2], voffB[2];
#pragma unroll
    for (int i = 0; i < 2; ++i) { int R, C; stage_rc(tid * 16 + i * 8192, R, C); const int Rb = Epi::PERM ? ((R & ~31) + perm32(R & 31)) : R;
        voffA[i] = (unsigned)(R * K + C) * 2u; voffB[i] = (unsigned)(Rb * K + C) * 2u; }
    const size_t kstep = (size_t)(BK * 2);
    const size_t hstep = (size_t)HALF * K * 2;
    const size_t tstep = 2 * hstep;
    const unsigned ldsw = (unsigned)wid * 1024u;
    const int aoff = lds_byte(wr * 64 + fr, fq * 8), boff = lds_byte(wc * 32 + fr, fq * 8);
#define PG8_SA(b, h) (((b) * 2 + (h)) * HTB)
#define PG8_SB(b, h) ((4 + (b) * 2 + (h)) * HTB)
#define PG8_STAGE(bufoff, gbase, voff) do { _Pragma("unroll") for (int _i = 0; _i < 2; ++_i) \
        __builtin_amdgcn_global_load_lds((const unsigned*)((const char*)(gbase) + (voff)[_i]), (PG8_LAS unsigned*)(lds + (bufoff) + ldsw + _i * 8192), 16, 0, 0); } while (0)
#define PG8_LDA(dst, b, h) do { _Pragma("unroll") for (int m = 0; m < 4; ++m) _Pragma("unroll") for (int k = 0; k < 2; ++k) dst[m][k] = *(const PG8_LAS bf16x8*)(lds + PG8_SA(b, h) + aoff + m * 2048 + k * 1024); } while (0)
#define PG8_LDB(dst, b, h) do { _Pragma("unroll") for (int n = 0; n < 2; ++n) _Pragma("unroll") for (int k = 0; k < 2; ++k) dst[n][k] = *(const PG8_LAS bf16x8*)(lds + PG8_SB(b, h) + boff + n * 2048 + k * 1024); } while (0)
#define PG8_MMA(ai, bj, At, Bt) do { __builtin_amdgcn_s_setprio(1); _Pragma("unroll") for (int m = 0; m < 4; ++m) _Pragma("unroll") for (int n = 0; n < 2; ++n) _Pragma("unroll") for (int k = 0; k < 2; ++k) \
        acc[ai][bj][m][n] = __builtin_amdgcn_mfma_f32_16x16x32_bf16(Bt[n][k], At[m][k], acc[ai][bj][m][n], 0, 0, 0); __builtin_amdgcn_s_setprio(0); } while (0)
#define PG8_WAIT_V(n) asm volatile("s_waitcnt vmcnt(" #n ")" ::: "memory")
#define PG8_WAIT_L(n) asm volatile("s_waitcnt lgkmcnt(" #n ")" ::: "memory")
#define PG8_BAR __builtin_amdgcn_s_barrier()
#define PG8_SCHED __builtin_amdgcn_sched_barrier(0)
    Unit cur, nxt; int ui = 0;
    if (!S.next(0, cur)) return;
    f32x4 acc[2][2][4][2];
#pragma unroll
    for (int a = 0; a < 2; ++a)
#pragma unroll
        for (int b = 0; b < 2; ++b)
#pragma unroll
            for (int m = 0; m < 4; ++m)
#pragma unroll
                for (int n = 0; n < 2; ++n) acc[a][b][m][n] = (f32x4){0.f, 0.f, 0.f, 0.f};
    bf16x8 At[4][2], B0[2][2], B1[2][2];
    const char* cA = (const char*)g.A + (size_t)cur.pm * tstep; const char* cB = (const char*)g.Bt + (size_t)cur.pn * tstep;
    S.a_ready(cur);
    if constexpr (SP2) {
        PG8_STAGE(PG8_SB(0, 0), cB, voffB); PG8_STAGE(PG8_SB(0, 1), cB + hstep, voffB); PG8_STAGE(PG8_SA(0, 0), cA, voffA); PG8_STAGE(PG8_SA(0, 1), cA + hstep, voffA);
        if (wr == 1) PG8_BAR;
        PG8_WAIT_V(2); PG8_BAR;
        PG8_STAGE(PG8_SB(1, 0), cB + kstep, voffB); PG8_STAGE(PG8_SA(1, 0), cA + kstep, voffA); PG8_STAGE(PG8_SB(1, 1), cB + hstep + kstep, voffB);
        PG8_WAIT_V(6); PG8_BAR;
    } else {
        PG8_STAGE(PG8_SB(0, 0), cB, voffB); PG8_STAGE(PG8_SA(0, 0), cA, voffA); PG8_STAGE(PG8_SB(0, 1), cB + hstep, voffB); PG8_STAGE(PG8_SA(0, 1), cA + hstep, voffA);
        if (wr == 1) PG8_BAR;
        PG8_WAIT_V(4); PG8_BAR;
        PG8_STAGE(PG8_SB(1, 0), cB + kstep, voffB); PG8_STAGE(PG8_SA(1, 0), cA + kstep, voffA); PG8_STAGE(PG8_SB(1, 1), cB + hstep + kstep, voffB);
        PG8_WAIT_V(6); PG8_BAR;
    }
    for (;;) {
        const bool has_next = S.next(ui + 1, nxt);
        const char* nA = has_next ? (const char*)g.A + (size_t)nxt.pm * tstep : cA; const char* nB = has_next ? (const char*)g.Bt + (size_t)nxt.pn * tstep : cB;
        for (int t = 0; t < nt; t += 2) {
            const bool last = (t == nt - 2);
            const char* a1 = cA + (size_t)(t + 1) * kstep;
            const char* a2 = last ? nA : cA + (size_t)(t + 2) * kstep; const char* b2 = last ? nB : cB + (size_t)(t + 2) * kstep;
            const char* a3 = a2 + kstep; const char* b3 = b2 + kstep;
            if (last && has_next) S.a_ready(nxt);
            if constexpr (SP2) {
            PG8_LDB(B0, 0, 0); PG8_LDB(B1, 0, 1); PG8_SCHED; PG8_LDA(At, 0, 0); PG8_STAGE(PG8_SA(1, 1), a1 + hstep, voffA);
            PG8_WAIT_V(8); PG8_WAIT_L(0); PG8_BAR; PG8_MMA(0, 0, At, B0); PG8_MMA(0, 1, At, B1); PG8_BAR; PG8_SCHED;
            PG8_LDA(At, 0, 1); PG8_STAGE(PG8_SB(0, 0), b2, voffB); PG8_STAGE(PG8_SB(0, 1), b2 + hstep, voffB); PG8_STAGE(PG8_SA(0, 0), a2, voffA);
            PG8_WAIT_V(8); PG8_WAIT_L(0); PG8_BAR; PG8_MMA(1, 0, At, B0); PG8_MMA(1, 1, At, B1); PG8_BAR; PG8_SCHED;
            PG8_LDB(B0, 1, 0); PG8_LDB(B1, 1, 1); PG8_SCHED; PG8_LDA(At, 1, 0); PG8_STAGE(PG8_SA(0, 1), a2 + hstep, voffA);
            PG8_WAIT_V(8); PG8_WAIT_L(0); PG8_BAR; PG8_MMA(0, 0, At, B0); PG8_MMA(0, 1, At, B1); PG8_BAR; PG8_SCHED;
            PG8_LDA(At, 1, 1); PG8_STAGE(PG8_SB(1, 0), b3, voffB); PG8_STAGE(PG8_SB(1, 1), b3 + hstep, voffB); PG8_STAGE(PG8_SA(1, 0), a3, voffA);
            PG8_WAIT_V(8); PG8_WAIT_L(0); PG8_BAR; PG8_MMA(1, 0, At, B0); PG8_MMA(1, 1, At, B1); PG8_BAR; PG8_SCHED;
            } else {
            PG8_LDB(B0, 0, 0); PG8_SCHED; PG8_LDA(At, 0, 0); PG8_STAGE(PG8_SA(1, 1), a1 + hstep, voffA);
            PG8_WAIT_L(8); PG8_BAR; PG8_WAIT_L(0); PG8_MMA(0, 0, At, B0); PG8_BAR; PG8_SCHED;
            PG8_LDB(B1, 0, 1); PG8_STAGE(PG8_SB(0, 0), b2, voffB);
            PG8_BAR; PG8_WAIT_L(0); PG8_MMA(0, 1, At, B1); PG8_BAR;
            PG8_LDA(At, 0, 1); PG8_STAGE(PG8_SA(0, 0), a2, voffA);
            PG8_BAR; PG8_WAIT_L(0); PG8_MMA(1, 0, At, B0); PG8_BAR; PG8_SCHED;
            PG8_STAGE(PG8_SB(0, 1), b2 + hstep, voffB);
            PG8_WAIT_V(6); PG8_BAR; PG8_MMA(1, 1, At, B1); PG8_BAR;
            PG8_LDB(B0, 1, 0); PG8_SCHED; PG8_LDA(At, 1, 0); PG8_STAGE(PG8_SA(0, 1), a2 + hstep, voffA);
            PG8_WAIT_L(8); PG8_BAR; PG8_WAIT_L(0); PG8_MMA(0, 0, At, B0); PG8_BAR; PG8_SCHED;
            PG8_LDB(B1, 1, 1); PG8_STAGE(PG8_SB(1, 0), b3, voffB);
            PG8_BAR; PG8_WAIT_L(0); PG8_MMA(0, 1, At, B1); PG8_BAR;
            PG8_LDA(At, 1, 1); PG8_STAGE(PG8_SA(1, 0), a3, voffA);
            PG8_BAR; PG8_WAIT_L(0); PG8_MMA(1, 0, At, B0); PG8_BAR; PG8_SCHED;
            PG8_STAGE(PG8_SB(1, 1), b3 + hstep, voffB);
            PG8_WAIT_V(6); PG8_BAR; PG8_MMA(1, 1, At, B1); PG8_BAR;
            }
        }
        if constexpr (ALIGN_EPI) { if (wr == 0) PG8_BAR; }
        if constexpr (!Epi::AFTER_DRAIN) { E(acc, cur, wr, wc, fr, fq); S.done(cur); }
        if (!has_next) break;
#pragma unroll
        for (int a = 0; a < 2; ++a)
#pragma unroll
            for (int b = 0; b < 2; ++b)
#pragma unroll
                for (int m = 0; m < 4; ++m)
#pragma unroll
                    for (int n = 0; n < 2; ++n) acc[a][b][m][n] = (f32x4){0.f, 0.f, 0.f, 0.f};
        cur = nxt; cA = nA; cB = nB; ++ui;
        if constexpr (ALIGN_EPI) { if (wr == 1) PG8_BAR; }
    }
    PG8_WAIT_V(0);
    if constexpr (!ALIGN_EPI) { if (wr == 0) PG8_BAR; }
    PG8_BAR;
    if constexpr (Epi::AFTER_DRAIN) { E.fused(acc, cur, wr, wc, fr, fq, lds, wid, lane); S.done(cur); }
#undef PG8_SA
#undef PG8_SB
#undef PG8_STAGE
#undef PG8_LDA
#undef PG8_LDB
#undef PG8_MMA
#undef PG8_WAIT_V
#undef PG8_WAIT_L
#undef PG8_BAR
#undef PG8_SCHED
}
}

#define XB_TMO      128
#define XB_XCNT(j)  (256  + 64 * (j))
#define XB_XSUB(j)  (1280 + 64 * (j))
#define XB_XGEN(j)  (2304 + 64 * (j))
#define XB_TOP      3328
#define XB_TOPGEN   3392
#define XCD_BAR_WORDS 3456
#define XB_SPIN_CAP (1u << 18)

__device__ __forceinline__ unsigned xb_ld(unsigned* p)              { return __hip_atomic_load(p, __ATOMIC_RELAXED, __HIP_MEMORY_SCOPE_AGENT); }
__device__ __forceinline__ unsigned xb_add(unsigned* p, unsigned v) { return __hip_atomic_fetch_add(p, v, __ATOMIC_RELAXED, __HIP_MEMORY_SCOPE_AGENT); }
__device__ __forceinline__ unsigned xb_xcc_id() { return (unsigned)__builtin_amdgcn_s_getreg((3 << 11) | 20) & 0xFu; }
#define XB_SPIN(cond, bar) do { unsigned _sp = 0; while (cond) { __builtin_amdgcn_s_sleep(1); \
    if ((++_sp & 255u) == 0u) { if (xb_ld(&(bar)[XB_TMO])) break; if (_sp > XB_SPIN_CAP) { atomicAdd(&(bar)[XB_TMO], 1u); break; } } } } while (0)

struct XcdBarrier {
    unsigned* bar; unsigned x;
    volatile LAS unsigned* st;
};

__device__ __forceinline__ XcdBarrier xcd_barrier_post(unsigned* bar, volatile LAS unsigned* st) {
    XcdBarrier b; b.bar = bar; b.x = xb_xcc_id(); b.st = st;
    if (threadIdx.x == 0) (void)xb_add(&bar[XB_XCNT(b.x)], 1u);
    return b;
}
__device__ __forceinline__ void xcd_barrier_complete(unsigned* bar, unsigned x, unsigned& nloc, unsigned& nx) {
    const unsigned G = gridDim.x * gridDim.y * gridDim.z;
    unsigned sum, cnt, mine, sp = 0u;
    for (;;) {
        sum = 0u; cnt = 0u; mine = 0u;
#pragma unroll
        for (unsigned j = 0; j < 16; ++j) { const unsigned c = xb_ld(&bar[XB_XCNT(j)]); sum += c; cnt += (c > 0u) ? 1u : 0u; mine = (j == x) ? c : mine; }
        if (sum == G) break;
        __builtin_amdgcn_s_sleep(1);
        if ((++sp & 255u) == 0u) { if (xb_ld(&bar[XB_TMO])) break; if (sp > XB_SPIN_CAP) { atomicAdd(&bar[XB_TMO], 1u); break; } }
    }
    nloc = mine > 0u ? mine : 1u; nx = cnt > 0u ? cnt : 1u;
}

__device__ __forceinline__ void xcd_barrier(const XcdBarrier& b) {
    asm volatile("s_waitcnt vmcnt(0)" ::: "memory");
    __syncthreads();
    if (threadIdx.x == 0) {
        unsigned* bar = b.bar;
        __builtin_amdgcn_s_waitcnt(0);
        unsigned nloc = b.st[0], nx = b.st[1];
        if (nloc == 0u) { xcd_barrier_complete(bar, b.x, nloc, nx); b.st[0] = nloc; b.st[1] = nx; }
        const unsigned old = xb_add(&bar[XB_XSUB(b.x)], 1u);
        const unsigned gen = old / nloc;
        if (old + 1u == (gen + 1u) * nloc) {
            __builtin_amdgcn_fence(__ATOMIC_RELEASE, "agent");
            asm volatile("s_waitcnt vmcnt(0)" ::: "memory");
            const unsigned og = xb_add(&bar[XB_TOP], 1u);
            const unsigned tg = og / nx;
            if (og + 1u == (tg + 1u) * nx) xb_add(&bar[XB_TOPGEN], 1u);
            else XB_SPIN(xb_ld(&bar[XB_TOPGEN]) == tg, bar);
            __builtin_amdgcn_fence(__ATOMIC_ACQUIRE, "agent");
            xb_add(&bar[XB_XGEN(b.x)], 1u);
            asm volatile("s_waitcnt vmcnt(0)" ::: "memory");
        } else {
            XB_SPIN(xb_ld(&bar[XB_XGEN(b.x)]) == gen, bar);
            __builtin_amdgcn_fence(__ATOMIC_ACQUIRE, "agent");
            asm volatile("s_waitcnt vmcnt(0)" ::: "memory");
        }
    }
    __syncthreads();
}

constexpr int DM = 4096, NBATCH = 4, SEQ = 4096, MTOK = NBATCH * SEQ;
constexpr int AH = 8, ADV = 512, ADK = 256, AQKW = 2048;
constexpr int BH = 32, BHD = 128;
constexpr int L0COLS = 32800;
constexpr int CWID = 8192, CGR = 8, CCH = 128, CGC = 1024;
constexpr int NCHUNK = SEQ / 128;
constexpr float EPS = 1e-6f;
constexpr int C_AQ = 0, C_AK = 2048, C_AV = 4096, C_AO = 8192, C_AZ = 12288, C_GT = 16384, C_BQ = 16416, C_BK = 20512, C_BV = 24608, C_BZ = 28704;

#ifndef MK_N_LAUNCHES
#define MK_N_LAUNCHES 1
#endif
constexpr int NPHASE = 12;
constexpr int N_LAUNCHES = MK_N_LAUNCHES;

constexpr size_t MiB = 1u << 20;
constexpr size_t WS_CTL = 0, CTL_ZERO_BYTES = 1 * MiB;
constexpr int CW_BAR = 1024;
constexpr int CW_QUEUE = 8192;
constexpr size_t WS_MOD = 64 * 1024;
constexpr size_t WS_WG = 1 * MiB;
constexpr size_t WS_GATES = 2 * MiB;
constexpr size_t WS_R1 = 4 * MiB, WS_R2 = 5 * MiB;
constexpr size_t WS_DEC = 6 * MiB;
constexpr size_t WS_NST = 7 * MiB;
constexpr size_t WS_VSS = 10 * MiB;
constexpr size_t WS_W0A = 16 * MiB;
constexpr size_t WS_W0V = 208 * MiB;
constexpr size_t WS_H = 272 * MiB;
constexpr size_t WS_QKRAW = 400 * MiB;
constexpr size_t WS_CT = 16 * MiB;
constexpr size_t WS_WOUT0 = 528 * MiB;
constexpr size_t WS_GA = 592 * MiB;
constexpr size_t WS_BQK = 720 * MiB;
constexpr size_t WS_BZ = 976 * MiB;
constexpr size_t WS_VT = 1104 * MiB;
constexpr size_t WS_QC = 1360 * MiB;
constexpr size_t WS_KAF = 1424 * MiB, WS_KAB = 1488 * MiB;
constexpr size_t WS_KAFT = 1552 * MiB, WS_KABT = 1616 * MiB;
constexpr size_t WS_YCAT = 1680 * MiB;
constexpr size_t WS_END0 = 1936 * MiB;
constexpr size_t WS_W1A = 16 * MiB;
constexpr size_t WS_W1V = 144 * MiB;
constexpr size_t WS_WOUT1 = 208 * MiB;
constexpr size_t WS_UZ = 592 * MiB;
constexpr size_t WS_GVT = 848 * MiB;
constexpr size_t WS_Y1 = 1104 * MiB;
constexpr size_t WS_X1 = 1360 * MiB;
constexpr size_t WS_NEED = WS_END0;

constexpr int RING_BYTES = 131072;
constexpr int MISC_OFF = 147456 - 256;
constexpr int LDS_BYTES = 147456;
constexpr int NWAVES = 8, NTHREADS = 512;

#define GAS __attribute__((address_space(1)))
typedef unsigned short bf16;
typedef unsigned v4u __attribute__((ext_vector_type(4)));
typedef unsigned v2u __attribute__((ext_vector_type(2)));
typedef float f32x4 __attribute__((ext_vector_type(4)));
#define LDS_WAIT() asm volatile("s_waitcnt lgkmcnt(0)" ::: "memory")
__device__ __forceinline__ float bf2f(unsigned short b) { return __uint_as_float(((unsigned)b) << 16); }
__device__ __forceinline__ unsigned f2bf(float f) { unsigned u = __float_as_uint(f); return (u + 0x7fffu + ((u >> 16) & 1u)) >> 16; }
__device__ __forceinline__ unsigned pk2(float lo, float hi) { unsigned r; asm("v_cvt_pk_bf16_f32 %0, %1, %2" : "=v"(r) : "v"(lo), "v"(hi)); return r; }
__device__ __forceinline__ float lo16(unsigned w) { return __uint_as_float(w << 16); }
__device__ __forceinline__ float hi16(unsigned w) { return __uint_as_float(w & 0xffff0000u); }
__device__ __forceinline__ float siluf_(float x) { return x * __builtin_amdgcn_rcpf(1.0f + __builtin_amdgcn_exp2f(-1.4426950408889634f * x)); }
__device__ __forceinline__ float logsigf_(float x) { return fminf(x, 0.f) - log1pf(__expf(-fabsf(x))); }
__device__ __forceinline__ float wave_sum(float v) {
#pragma unroll
    for (int o = 1; o < 64; o <<= 1) v += __shfl_xor(v, o);
    return v;
}

struct Args {
    const float* in[21]; float* out; unsigned char* ws; int ph_lo, ph_hi;
};
struct Frame { LAS unsigned char* lds; int tid, lane, wave, G, bid; };

__device__ __forceinline__ void transpose_item(const float* W, int ldw, int K, bf16* WT, int dst_row0, int src_col0, int kb, LAS float* scr, int lane) {
    const int k0 = 64 * kb;
    float tv[32];
    const float* wp = W + (size_t)(k0 + (lane >> 5)) * ldw + src_col0 + (lane & 31);
#pragma unroll
    for (int i = 0; i < 32; ++i) tv[i] = __builtin_nontemporal_load(wp + (size_t)(2 * i) * ldw);
#pragma unroll
    for (int i = 0; i < 32; ++i) scr[(2 * i + (lane >> 5)) * 33 + (lane & 31)] = tv[i];
    LDS_WAIT(); asm volatile("" ::: "memory");
    const int c = lane & 7;
#pragma unroll
    for (int j = 0; j < 4; ++j) { const int n = (lane >> 3) + 8 * j; const LAS float* s = scr + (8 * c) * 33 + n;
        v4u o; o.x = pk2(s[0 * 33], s[1 * 33]); o.y = pk2(s[2 * 33], s[3 * 33]); o.z = pk2(s[4 * 33], s[5 * 33]); o.w = pk2(s[6 * 33], s[7 * 33]);
        *(v4u*)(WT + (size_t)(dst_row0 + n) * K + k0 + 8 * c) = o; }
    LDS_WAIT(); asm volatile("" ::: "memory");
}
__device__ __forceinline__ int map_w0a(int n) {
    if (n < 4096) return n;
    if (n < 12288) { const int t = (n - 4096) >> 8, w = (n - 4096) & 255; return (w < 128 ? C_AO : C_AZ) + 128 * t + (w & 127); }
    if (n < 20480) return C_BQ + (n - 12288);
    return C_BZ + (n - 20480);
}
__device__ __forceinline__ int map_w1a(int n) {
    const int t = n >> 8, w = n & 255; return (w < 128 ? 0 : 16384) + 128 * t + (w & 127);
}
__device__ __forceinline__ void ada_items(const Args& A, Frame& F, int dummy) {
    LAS float* sc = (LAS float*)(F.lds);
    for (int it = F.bid; it < 2 * 64 * 6; it += F.G) {
        const int layer = it / 384, r = it % 384, kb = r / 6, cg = r % 6, k0 = kb * 64;
        const float* w = layer ? A.in[14] : A.in[3];
        float* mod = (float*)(A.ws + WS_MOD) + (size_t)(layer + 2 * dummy) * 4 * 12288;
        __syncthreads();
        if (F.tid < 256) { const int b = F.tid >> 6, kk = F.tid & 63; sc[b * 64 + kk] = siluf_(A.in[1][b * DM + k0 + kk]); }
        __syncthreads();
        const int j0 = cg * 2048 + 4 * F.tid;
        f32x4 a0 = {0.f, 0.f, 0.f, 0.f}, a1 = a0, a2 = a0, a3 = a0;
#pragma unroll 8
        for (int kk = 0; kk < 64; ++kk) { const f32x4 wv = __builtin_nontemporal_load((const f32x4*)(w + (size_t)(k0 + kk) * 12288 + j0));
            a0 += wv * sc[kk]; a1 += wv * sc[64 + kk]; a2 += wv * sc[128 + kk]; a3 += wv * sc[192 + kk]; }
#pragma unroll
        for (int i = 0; i < 4; ++i) { atomicAdd(mod + 0 * 12288 + j0 + i, a0[i]); atomicAdd(mod + 1 * 12288 + j0 + i, a1[i]); atomicAdd(mod + 2 * 12288 + j0 + i, a2[i]); atomicAdd(mod + 3 * 12288 + j0 + i, a3[i]); }
    }
    __syncthreads();
}
__device__ __forceinline__ void p0_prep(const Args& A, Frame& F) {
    LAS float* scr = (LAS float*)(F.lds + 4096 + F.wave * 8704);
    const int gw = F.bid * NWAVES + F.wave, NGW = F.G * NWAVES;
    bf16* W0A = (bf16*)(A.ws + WS_W0A); bf16* W0V = (bf16*)(A.ws + WS_W0V); bf16* WO0 = (bf16*)(A.ws + WS_WOUT0);
    constexpr int I_A = 64 * 768, I_V = 64 * 256, I_O = 128 * 128, I_G = 64;
    for (int it = gw; it < I_A + I_V + I_O + I_G; it += NGW) {
        int r = it;
        if (r < I_G) { transpose_item(A.in[5], L0COLS, DM, (bf16*)(A.ws + WS_WG), 0, C_GT, r, scr, F.lane); continue; } r -= I_G;
        if (r < I_A) { const int kb = r / 768, db = r % 768; transpose_item(A.in[5], L0COLS, DM, W0A, 32 * db, map_w0a(32 * db), kb, scr, F.lane); continue; } r -= I_A;
        if (r < I_V) { const int kb = r / 256, db = r % 256, n = 32 * db; transpose_item(A.in[5], L0COLS, DM, W0V, n, n < 4096 ? C_AV + n : C_BV + (n - 4096), kb, scr, F.lane); continue; } r -= I_V;
        { const int kb = r / 128, db = r % 128; transpose_item(A.in[12], DM, 8192, WO0, 32 * db, 32 * db, kb, scr, F.lane); }
    }
}
__device__ __forceinline__ void p7_prep1(const Args& A, Frame& F) {
    LAS float* scr = (LAS float*)(F.lds + 4096 + F.wave * 8704);
    const int gw = F.bid * NWAVES + F.wave, NGW = F.G * NWAVES;
    bf16* W1A = (bf16*)(A.ws + WS_W1A); bf16* W1V = (bf16*)(A.ws + WS_W1V); bf16* WO1 = (bf16*)(A.ws + WS_WOUT1);
    constexpr int I_A = 64 * 512, I_V = 64 * 256, I_O = 128 * 128;
    for (int it = gw; it < I_A + I_V + I_O; it += NGW) {
        int r = it;
        if (r < I_A) { const int kb = r / 512, db = r % 512; transpose_item(A.in[16], 3 * CWID, DM, W1A, 32 * db, map_w1a(32 * db), kb, scr, F.lane); continue; } r -= I_A;
        if (r < I_V) { const int kb = r / 256, db = r % 256; transpose_item(A.in[16], 3 * CWID, DM, W1V, 32 * db, 8192 + 32 * db, kb, scr, F.lane); continue; } r -= I_V;
        { const int kb = r / 128, db = r % 128; transpose_item(A.in[20], DM, 8192, WO1, 32 * db, 32 * db, kb, scr, F.lane); }
    }
}
template <bool IN_BF16> __device__ __forceinline__ void norm_rows(const Args& A, Frame& F, const void* xin, const float* g, const float* mod, const float* adab, bf16* H) {
    LAS float* PA = (LAS float*)F.lds; LAS float* PS = PA + NBATCH * DM;
    __syncthreads();
    for (int e = F.tid; e < NBATCH * DM; e += NTHREADS) { const int b = e >> 12, c = e & (DM - 1);
        PA[e] = g[c] * (1.0f + mod[(size_t)b * 12288 + DM + c] + adab[DM + c]); PS[e] = mod[(size_t)b * 12288 + c] + adab[c]; }
    __syncthreads();
    const int gw = F.bid * NWAVES + F.wave, NGW = F.G * NWAVES;
    typedef typename std::conditional<IN_BF16, v4u, f32x4>::type xv_t;
    constexpr int NV = IN_BF16 ? 8 : 16;
    xv_t xa[NV], xb[NV];
#define NR_LOAD(X_, m_) do { if ((m_) < MTOK) { _Pragma("unroll") for (int j = 0; j < 8; ++j) { \
            if (IN_BF16) X_[j] = *(const xv_t*)((const bf16*)xin + (size_t)(m_) * DM + 512 * j + 8 * F.lane); \
            else { X_[2 * j] = *(const xv_t*)((const float*)xin + (size_t)(m_) * DM + 512 * j + 8 * F.lane); X_[2 * j + 1] = *(const xv_t*)((const float*)xin + (size_t)(m_) * DM + 512 * j + 8 * F.lane + 4); } } } } while (0)
#define NR_PROC(X_, m_) do { if ((m_) < MTOK) { float v[8][8]; float s = 0.f; \
            _Pragma("unroll") for (int j = 0; j < 8; ++j) { \
                if (IN_BF16) { const v4u w = __builtin_bit_cast(v4u, X_[j]); v[j][0] = lo16(w.x); v[j][1] = hi16(w.x); v[j][2] = lo16(w.y); v[j][3] = hi16(w.y); v[j][4] = lo16(w.z); v[j][5] = hi16(w.z); v[j][6] = lo16(w.w); v[j][7] = hi16(w.w); } \
                else { const f32x4 p0 = __builtin_bit_cast(f32x4, X_[IN_BF16 ? j : 2 * j]), p1 = __builtin_bit_cast(f32x4, X_[IN_BF16 ? j : 2 * j + 1]); v[j][0] = p0[0]; v[j][1] = p0[1]; v[j][2] = p0[2]; v[j][3] = p0[3]; v[j][4] = p1[0]; v[j][5] = p1[1]; v[j][6] = p1[2]; v[j][7] = p1[3]; } \
                s += ((v[j][0] * v[j][0] + v[j][1] * v[j][1]) + (v[j][2] * v[j][2] + v[j][3] * v[j][3])) + ((v[j][4] * v[j][4] + v[j][5] * v[j][5]) + (v[j][6] * v[j][6] + v[j][7] * v[j][7])); } \
            const float rstd = rsqrtf(wave_sum(s) * (1.f / DM) + EPS); const int pb = ((m_) / SEQ) * DM + 8 * F.lane; \
            _Pragma("unroll") for (int j = 0; j < 8; ++j) { const f32x4 a0 = *(const LAS f32x4*)(PA + pb + 512 * j), a1 = *(const LAS f32x4*)(PA + pb + 512 * j + 4), s0 = *(const LAS f32x4*)(PS + pb + 512 * j), s1 = *(const LAS f32x4*)(PS + pb + 512 * j + 4); \
                v4u o; o.x = pk2(v[j][0] * rstd * a0[0] + s0[0], v[j][1] * rstd * a0[1] + s0[1]); o.y = pk2(v[j][2] * rstd * a0[2] + s0[2], v[j][3] * rstd * a0[3] + s0[3]); \
                o.z = pk2(v[j][4] * rstd * a1[0] + s1[0], v[j][5] * rstd * a1[1] + s1[1]); o.w = pk2(v[j][6] * rstd * a1[2] + s1[2], v[j][7] * rstd * a1[3] + s1[3]); \
                *(v4u*)(H + (size_t)(m_) * DM + 512 * j + 8 * F.lane) = o; } } } while (0)
    NR_LOAD(xa, gw);
#pragma unroll 1
    for (int m = gw; m < MTOK; m += 2 * NGW) {
        NR_LOAD(xb, m + NGW); __builtin_amdgcn_sched_barrier(0);
        NR_PROC(xa, m); __builtin_amdgcn_sched_barrier(0);
        NR_LOAD(xa, m + 2 * NGW); __builtin_amdgcn_sched_barrier(0);
        NR_PROC(xb, m + NGW); __builtin_amdgcn_sched_barrier(0);
    }
#undef NR_LOAD
#undef NR_PROC
    __syncthreads();
}


typedef short bf16x8 __attribute__((ext_vector_type(8)));
#define MFMA16(a, b, c) __builtin_amdgcn_mfma_f32_16x16x32_bf16((a), (b), (c), 0, 0, 0)
__device__ __forceinline__ void gates_mfma(const Args& A, Frame& F) {
    const bf16* H = (const bf16*)(A.ws + WS_H); const bf16* WG = (const bf16*)(A.ws + WS_WG); float* GT = (float*)(A.ws + WS_GATES);
    const int fr = F.lane & 15, fq = F.lane >> 4, mt = F.wave >> 1, nt = F.wave & 1;
    for (int rb = F.bid; rb < MTOK / 64; rb += F.G) {
        const bf16* ap = H + (size_t)(rb * 64 + mt * 16 + fr) * DM + 8 * fq; const bf16* bp = WG + (size_t)(nt * 16 + fr) * DM + 8 * fq;
        f32x4 acc = {0.f, 0.f, 0.f, 0.f};
#pragma unroll 16
        for (int ks = 0; ks < DM / 32; ++ks) { const bf16x8 a = *(const bf16x8*)(ap + 32 * ks), b = *(const bf16x8*)(bp + 32 * ks); acc = MFMA16(a, b, acc); }
        const float bias = A.in[7][nt * 16 + fr];
#pragma unroll
        for (int i = 0; i < 4; ++i) GT[(size_t)(rb * 64 + mt * 16 + 4 * fq + i) * 32 + nt * 16 + fr] = acc[i] + bias;
    }
}


__device__ __forceinline__ float wave_incl_scan(float x, int lane) {
#pragma unroll
    for (int o = 1; o < 64; o <<= 1) { const float y = __shfl_up(x, o); if (lane >= o) x += y; }
    return x;
}
__device__ __forceinline__ void mid_opt(const Args& A, Frame& F) {
    const float* GT = (const float*)(A.ws + WS_GATES);
    float* R1 = (float*)(A.ws + WS_R1); float* R2 = (float*)(A.ws + WS_R2); float* DEC = (float*)(A.ws + WS_DEC);
    const bf16* QKR = (const bf16*)(A.ws + WS_QKRAW);
    bf16* QC = (bf16*)(A.ws + WS_QC); bf16* KAF = (bf16*)(A.ws + WS_KAF); bf16* KAB = (bf16*)(A.ws + WS_KAB); bf16* KAFT = (bf16*)(A.ws + WS_KAFT); bf16* KABT = (bf16*)(A.ws + WS_KABT);
    LAS unsigned short* Tf = (LAS unsigned short*)F.lds;
    LAS unsigned short* Tb = (LAS unsigned short*)(F.lds + 69632);
    LAS float* L = (LAS float*)(F.lds + 139264);
    LAS float *af = L, *ab = L + 128, *wt = L + 256;
    LAS float* cwl = L + 264;
    const float* cw = A.in[6];
    for (int it = F.bid; it < NBATCH * AH * NCHUNK; it += F.G) {
        const int b = it >> 8, h = (it >> 5) & 7, j = it & 31; const int m0 = b * SEQ + j * 128;
            const int s_lo = F.tid >> 5, c8 = (F.tid & 31) * 8; const int cq = h * 256 + c8, ck = 2048 + h * 256 + c8;
            v4u qA[2][3], kA[2][3], qB[2][3], kB[2][3];
#define MO_LOAD(Q_, K_, p0_) do { int sl_ = s_lo; asm volatile("" : "+v"(sl_)); _Pragma("unroll") for (int pp = 0; pp < 2; ++pp) { const int s = ((p0_) + pp) * 16 + sl_, tok = j * 128 + s; const size_t row = (size_t)(m0 + s); const v4u z4 = {0u, 0u, 0u, 0u}; \
                Q_[pp][0] = tok > 0 ? *(const v4u*)(QKR + (row - 1) * DM + cq) : z4; Q_[pp][1] = *(const v4u*)(QKR + row * DM + cq); Q_[pp][2] = tok < SEQ - 1 ? *(const v4u*)(QKR + (row + 1) * DM + cq) : z4; \
                K_[pp][0] = tok > 0 ? *(const v4u*)(QKR + (row - 1) * DM + ck) : z4; K_[pp][1] = *(const v4u*)(QKR + row * DM + ck); K_[pp][2] = tok < SEQ - 1 ? *(const v4u*)(QKR + (row + 1) * DM + ck) : z4; } } while (0)
            MO_LOAD(qA, kA, 0); MO_LOAD(qB, kB, 2);
        float cwv[3];
#pragma unroll
        for (int k = 0; k < 3; ++k) { const int c = F.tid; cwv[k] = cw[k * DM + (c < 256 ? h * 256 + c : 2048 + h * 256 + (c - 256))]; }
        float g_if = 0.f, g_ff = 0.f, g_ib = 0.f, g_fb = 0.f;
        if (F.tid < 128) { const float* gr = GT + (size_t)(m0 + F.tid) * 32; g_if = gr[h]; g_ff = gr[8 + h]; g_ib = gr[16 + h]; g_fb = gr[24 + h]; }
        __builtin_amdgcn_sched_barrier(0);
        __syncthreads();
#pragma unroll
        for (int k = 0; k < 3; ++k) cwl[k * 512 + F.tid] = cwv[k];
        float igf = 0.f, igb = 0.f, lff = 0.f, lfb = 0.f, pf = 0.f, pb = 0.f;
        if (F.tid < 128) {
            igf = g_if; lff = logsigf_(g_ff); igb = g_ib; lfb = logsigf_(g_fb);
            pf = wave_incl_scan(lff, F.lane); pb = wave_incl_scan(lfb, F.lane);
            if (F.tid == 63) { wt[0] = pf; wt[1] = pb; } }
        __syncthreads();
        if (F.tid < 128) { if (F.tid >= 64) { pf += wt[0]; pb += wt[1]; } if (F.tid == 127) { wt[2] = pf; wt[3] = pb; } }
        __syncthreads();
        if (F.tid < 128) { const int s = F.tid; const float gLf = wt[2], gLb = wt[3];
            const float gf = pf, gb = gLb - pb + lfb;
            af[s] = __expf(igf + gLf - gf); ab[s] = __expf(igb + gLb - gb);
            const size_t o = (size_t)(b * AH + h) * SEQ + j * 128 + s, od = (size_t)NBATCH * AH * SEQ;
            R1[o] = __expf(gf); R2[o] = __expf(gf - gLf); R1[od + o] = __expf(gb); R2[od + o] = __expf(gb - gLb);
            if (s == 0) { DEC[(b * AH + h) * NCHUNK + j] = __expf(gLf); DEC[NBATCH * AH * NCHUNK + (b * AH + h) * NCHUNK + j] = __expf(gLb); } }
        __syncthreads();
        {
#define MO_PROC(Q_, K_, p0_) do { int sl_ = s_lo; asm volatile("" : "+v"(sl_)); _Pragma("unroll") for (int pp = 0; pp < 2; ++pp) { const int s = ((p0_) + pp) * 16 + sl_; const size_t row = (size_t)(m0 + s); \
                const unsigned qa[4] = {Q_[pp][0].x, Q_[pp][0].y, Q_[pp][0].z, Q_[pp][0].w}, qb[4] = {Q_[pp][1].x, Q_[pp][1].y, Q_[pp][1].z, Q_[pp][1].w}, qd[4] = {Q_[pp][2].x, Q_[pp][2].y, Q_[pp][2].z, Q_[pp][2].w}; \
                const unsigned ka[4] = {K_[pp][0].x, K_[pp][0].y, K_[pp][0].z, K_[pp][0].w}, kb[4] = {K_[pp][1].x, K_[pp][1].y, K_[pp][1].z, K_[pp][1].w}, kd[4] = {K_[pp][2].x, K_[pp][2].y, K_[pp][2].z, K_[pp][2].w}; \
                float qv[8], kv[8]; \
                _Pragma("unroll") for (int i = 0; i < 4; ++i) { \
                    const f32x4 t0 = *(const LAS f32x4*)(cwl + c8 + 4 * (i >> 1)), t1 = *(const LAS f32x4*)(cwl + 512 + c8 + 4 * (i >> 1)), t2 = *(const LAS f32x4*)(cwl + 1024 + c8 + 4 * (i >> 1)); \
                    const f32x4 u0 = *(const LAS f32x4*)(cwl + 256 + c8 + 4 * (i >> 1)), u1 = *(const LAS f32x4*)(cwl + 768 + c8 + 4 * (i >> 1)), u2 = *(const LAS f32x4*)(cwl + 1280 + c8 + 4 * (i >> 1)); \
                    const int e0 = 2 * (i & 1); \
                    qv[2 * i] = siluf_(t0[e0] * lo16(qa[i]) + t1[e0] * lo16(qb[i]) + t2[e0] * lo16(qd[i])) * 0.0625f; \
                    qv[2 * i + 1] = siluf_(t0[e0 + 1] * hi16(qa[i]) + t1[e0 + 1] * hi16(qb[i]) + t2[e0 + 1] * hi16(qd[i])) * 0.0625f; \
                    kv[2 * i] = siluf_(u0[e0] * lo16(ka[i]) + u1[e0] * lo16(kb[i]) + u2[e0] * lo16(kd[i])); \
                    kv[2 * i + 1] = siluf_(u0[e0 + 1] * hi16(ka[i]) + u1[e0 + 1] * hi16(kb[i]) + u2[e0 + 1] * hi16(kd[i])); } \
                const float fa = af[s], fb = ab[s]; \
                v4u oq, of, ob; \
                oq.x = pk2(qv[0], qv[1]); oq.y = pk2(qv[2], qv[3]); oq.z = pk2(qv[4], qv[5]); oq.w = pk2(qv[6], qv[7]); \
                of.x = pk2(kv[0] * fa, kv[1] * fa); of.y = pk2(kv[2] * fa, kv[3] * fa); of.z = pk2(kv[4] * fa, kv[5] * fa); of.w = pk2(kv[6] * fa, kv[7] * fa); \
                ob.x = pk2(kv[0] * fb, kv[1] * fb); ob.y = pk2(kv[2] * fb, kv[3] * fb); ob.z = pk2(kv[4] * fb, kv[5] * fb); ob.w = pk2(kv[6] * fb, kv[7] * fb); \
                *(v4u*)(QC + row * AQKW + cq) = oq; *(v4u*)(KAF + row * AQKW + cq) = of; *(v4u*)(KAB + row * AQKW + cq) = ob; \
                const unsigned fw[4] = {of.x, of.y, of.z, of.w}, bw[4] = {ob.x, ob.y, ob.z, ob.w}; \
                _Pragma("unroll") for (int i = 0; i < 4; ++i) { \
                    Tf[(c8 + 2 * i) * 136 + s] = (unsigned short)(fw[i] & 0xffffu); Tf[(c8 + 2 * i + 1) * 136 + s] = (unsigned short)(fw[i] >> 16); \
                    Tb[(c8 + 2 * i) * 136 + s] = (unsigned short)(bw[i] & 0xffffu); Tb[(c8 + 2 * i + 1) * 136 + s] = (unsigned short)(bw[i] >> 16); } \
                __builtin_amdgcn_sched_barrier(0); } } while (0)
            MO_PROC(qA, kA, 0); __builtin_amdgcn_sched_barrier(0);
            MO_LOAD(qA, kA, 4); __builtin_amdgcn_sched_barrier(0);
            MO_PROC(qB, kB, 2); __builtin_amdgcn_sched_barrier(0);
            MO_LOAD(qB, kB, 6); __builtin_amdgcn_sched_barrier(0);
            MO_PROC(qA, kA, 4); __builtin_amdgcn_sched_barrier(0);
            MO_PROC(qB, kB, 6);
#undef MO_LOAD
#undef MO_PROC
        }
        __syncthreads();
#pragma unroll 2
        for (int p = 0; p < 8; ++p) {
            const int e = p * NTHREADS + F.tid, c = e >> 4, s8 = (e & 15) * 8;
            const v4u tf = *(const LAS v4u*)(Tf + c * 136 + s8), tb = *(const LAS v4u*)(Tb + c * 136 + s8);
            { const size_t to = ((size_t)(b * NCHUNK + j) * AQKW + h * 256 + c) * 128 + s8; *(v4u*)(KAFT + to) = tf; *(v4u*)(KABT + to) = tb; }
        }
    }
    __syncthreads();
}


__device__ __forceinline__ void scan_mfma(const Args& A, Frame& F) {
    const bf16* VT = (const bf16*)(A.ws + WS_VT); const float* DEC = (const float*)(A.ws + WS_DEC);
    bf16* CT = (bf16*)(A.ws + WS_CT); float* NST = (float*)(A.ws + WS_NST);
    LAS unsigned char* Kl = F.lds;
    LAS unsigned char* Vl = F.lds + 65536;
    const int fr = F.lane & 15, fq = F.lane >> 4, wvv = F.tid >> 6, wv = wvv >> 2, wd = wvv & 3;
    const int srow = ((F.tid >> 7) << 3) + (F.tid & 7), sch = (F.tid >> 3) & 15;
    for (int u = F.bid; u < 2 * NBATCH * AH * 4; u += F.G) {
        const int dir = u >> 7, b = (u >> 5) & 3, h = (u >> 2) & 7, vq = u & 3;
        const bf16* KT = (const bf16*)(A.ws + (dir ? WS_KABT : WS_KAFT));
        const bf16* kg = KT + ((size_t)(b * NCHUNK) * AQKW + h * ADK + srow) * 128 + sch * 8;
        const bf16* vg = VT + (size_t)(h * ADV + vq * 128 + srow) * MTOK + (size_t)b * SEQ + sch * 8;
        const bool do_n = (vq == 0) && (wv == 0);
        f32x4 acc[4][4];
#pragma unroll
        for (int a = 0; a < 4; ++a)
#pragma unroll
            for (int c = 0; c < 4; ++c) acc[a][c] = (f32x4){0.f, 0.f, 0.f, 0.f};
        float nacc[4] = {0.f, 0.f, 0.f, 0.f};
        const int j0 = dir ? (NCHUNK - 1) : 0;
        v4u sk[8], sv[4];
#pragma unroll
        for (int p = 0; p < 8; ++p) sk[p] = *(const v4u*)(kg + (size_t)j0 * AQKW * 128 + p * 32 * 128);
#pragma unroll
        for (int p = 0; p < 4; ++p) sv[p] = *(const v4u*)(vg + j0 * 128 + (size_t)(p * 32) * MTOK);
        const float* decp = DEC + (dir * NBATCH * AH + b * AH + h) * NCHUNK;
        float dec = decp[j0];
        __syncthreads();
#pragma unroll 1
        for (int jj = 0; jj < NCHUNK; ++jj) {
            const int j = dir ? (NCHUNK - 1 - jj) : jj; const int jn = dir ? (j - 1) : (j + 1); const bool more = (jj + 1 < NCHUNK);
            const float dec_next = more ? decp[jn] : 1.f;
#pragma unroll
            for (int p = 0; p < 8; ++p) { const int r_ = p * 32 + srow; *(LAS v4u*)(Kl + (sch * 256 + (r_ ^ (((r_ >> 4) & 3) << 2))) * 16) = sk[p]; }
#pragma unroll
            for (int p = 0; p < 4; ++p) *(LAS v4u*)(Vl + (sch * 128 + p * 32 + srow) * 16) = sv[p];
            __syncthreads();
            if (more) {
#pragma unroll
                for (int p = 0; p < 8; ++p) sk[p] = *(const v4u*)(kg + (size_t)jn * AQKW * 128 + p * 32 * 128);
#pragma unroll
                for (int p = 0; p < 4; ++p) sv[p] = *(const v4u*)(vg + jn * 128 + (size_t)(p * 32) * MTOK); }
            const size_t sidx = ((size_t)(dir * NBATCH + b) * AH + h) * NCHUNK + j;
            bf16* ct = CT + (sidx * ADV + vq * 128 + wv * 64 + fr) * ADK + wd * 64 + 16 * fq;
#pragma unroll
            for (int vt = 0; vt < 4; ++vt) { v4u w0, w1;
                w0.x = pk2(acc[0][vt][0], acc[0][vt][1]); w0.y = pk2(acc[0][vt][2], acc[0][vt][3]); w0.z = pk2(acc[1][vt][0], acc[1][vt][1]); w0.w = pk2(acc[1][vt][2], acc[1][vt][3]);
                w1.x = pk2(acc[2][vt][0], acc[2][vt][1]); w1.y = pk2(acc[2][vt][2], acc[2][vt][3]); w1.z = pk2(acc[3][vt][0], acc[3][vt][1]); w1.w = pk2(acc[3][vt][2], acc[3][vt][3]);
                *(v4u*)(ct + (size_t)(vt * 16) * ADK) = w0; *(v4u*)(ct + (size_t)(vt * 16) * ADK + 8) = w1; }
            if (do_n && fq == 0) {
#pragma unroll
                for (int dt = 0; dt < 4; ++dt) NST[sidx * ADK + wd * 64 + 16 * (fr >> 2) + 4 * dt + (fr & 3)] = nacc[dt]; }
#pragma unroll
            for (int dt = 0; dt < 4; ++dt) { nacc[dt] *= dec;
#pragma unroll
                for (int vt = 0; vt < 4; ++vt) acc[dt][vt] *= dec; }
            float np[4] = {0.f, 0.f, 0.f, 0.f};
#pragma unroll
            for (int ks = 0; ks < 4; ++ks) {
                bf16x8 af[4], bq[4];
#pragma unroll
                for (int dt = 0; dt < 4; ++dt) af[dt] = *(const LAS bf16x8*)(Kl + ((4 * ks + fq) * 256 + wd * 64 + 16 * (fr >> 2) + ((4 * dt + (fr & 3)) ^ ((fr >> 2) << 2))) * 16);
#pragma unroll
                for (int vt = 0; vt < 4; ++vt) bq[vt] = *(const LAS bf16x8*)(Vl + ((4 * ks + fq) * 128 + wv * 64 + vt * 16 + fr) * 16);
#pragma unroll
                for (int dt = 0; dt < 4; ++dt)
#pragma unroll
                    for (int vt = 0; vt < 4; ++vt) acc[dt][vt] = MFMA16(af[dt], bq[vt], acc[dt][vt]);
                if (do_n) {
#pragma unroll
                    for (int dt = 0; dt < 4; ++dt) { const v4u w = __builtin_bit_cast(v4u, af[dt]);
                        np[dt] += ((lo16(w.x) + hi16(w.x)) + (lo16(w.y) + hi16(w.y))) + ((lo16(w.z) + hi16(w.z)) + (lo16(w.w) + hi16(w.w))); } }
            }
            if (do_n) {
#pragma unroll
                for (int dt = 0; dt < 4; ++dt) { float t = np[dt]; t += __shfl_xor(t, 16); t += __shfl_xor(t, 32); nacc[dt] += t; } }
            dec = dec_next;
            __syncthreads();
        }
    }
}


__device__ __forceinline__ void natten_lds(const Args& A, Frame& F) {
    const bf16* BQK = (const bf16*)(A.ws + WS_BQK); const bf16* VT = (const bf16*)(A.ws + WS_VT) + (size_t)4096 * MTOK; const bf16* BZ = (const bf16*)(A.ws + WS_BZ);
    bf16* YC = (bf16*)(A.ws + WS_YCAT);
    constexpr int KB = 16 * 64 * 16, VB = 8 * 128 * 16, STG = KB + VB;
    LAS unsigned char* stg = F.lds; LAS float* rpl = (LAS float*)(F.lds + 2 * STG + 256);
    const int fr = F.lane & 15, fq = F.lane >> 4, wvv = F.tid >> 6;
    const int sk = (wvv << 3) + (F.tid & 7), sc = (F.tid >> 3) & 7;
    const int kpos = sk ^ (((sk >> 4) & 1) << 2);
    const int vpos0 = sk, vpos1 = sk + 64;
    const float* kgain = A.in[10]; const float* qgain = A.in[9];
    for (int u0 = F.bid; u0 < NBATCH * BH * 16; u0 += F.G) {
        int u = u0;
        if (F.G == 256) { const int i_ = u0 >> 8, x_ = u0 & 7, s_ = (u0 >> 3) & 31; u = ((i_ * 16 + x_ * 2 + (s_ >> 4)) << 4) | ((s_ + 2 * i_) & 15); }
        const int b = u >> 9, h = (u >> 4) & 31, r0 = (u & 15) * 4;
        const int klo = min(max(r0 - 4, 0), 56), khi = min(max(r0 + 3 - 4, 0), 56) + 7, nst = khi - klo + 1;
        const int r = r0 + (wvv >> 1), qg0 = 2 * (wvv & 1), rs = min(max(r - 4, 0), 56);
        const bf16* kg = BQK + ((size_t)b * SEQ + sk) * 8192 + 4096 + h * BHD + sc * 8;
        const bf16* vg = VT + (size_t)(h * BHD + sk) * MTOK + (size_t)b * SEQ + sc * 8;
        v4u ska0, ska1, sva0, sva1;
#define NA_LOAD(krow_) do { const size_t ko_ = (size_t)(krow_) * 64 * 8192; ska0 = *(const v4u*)(kg + ko_); ska1 = *(const v4u*)(kg + ko_ + 64); sva0 = *(const v4u*)(vg + (krow_) * 64); sva1 = *(const v4u*)(vg + (size_t)64 * MTOK + (krow_) * 64); } while (0)
        NA_LOAD(klo);
        v4u qwr[2][4];
#pragma unroll
        for (int g = 0; g < 2; ++g) { const size_t qtok = (size_t)b * SEQ + r * 64 + 16 * (qg0 + g) + fr;
#pragma unroll
            for (int ks = 0; ks < 4; ++ks) qwr[g][ks] = *(const v4u*)(BQK + qtok * 8192 + h * BHD + 32 * ks + 8 * fq); }
        const float rpv = (F.tid < 465) ? A.in[11][h * 465 + F.tid] : 0.f;
        __builtin_amdgcn_sched_barrier(0);
        __syncthreads();
        if (F.tid < 465) rpl[F.tid] = rpv;
        bf16x8 Qf[2][4];
#pragma unroll
        for (int g = 0; g < 2; ++g) {
            v4u qw[4]; float ss = 0.f;
#pragma unroll
            for (int ks = 0; ks < 4; ++ks) { qw[ks] = qwr[g][ks];
                const float e0 = lo16(qw[ks].x), e1 = hi16(qw[ks].x), e2 = lo16(qw[ks].y), e3 = hi16(qw[ks].y), e4 = lo16(qw[ks].z), e5 = hi16(qw[ks].z), e6 = lo16(qw[ks].w), e7 = hi16(qw[ks].w);
                ss += (e0 * e0 + e1 * e1) + (e2 * e2 + e3 * e3) + (e4 * e4 + e5 * e5) + (e6 * e6 + e7 * e7); }
            ss += __shfl_xor(ss, 16); ss += __shfl_xor(ss, 32);
            const float qs = rsqrtf(ss * (1.f / 128.f) + EPS) * 0.08838834764831845f;
#pragma unroll
            for (int ks = 0; ks < 4; ++ks) { const f32x4 g0 = *(const f32x4*)(qgain + 32 * ks + 8 * fq) * *(const f32x4*)(kgain + 32 * ks + 8 * fq), g1 = *(const f32x4*)(qgain + 32 * ks + 8 * fq + 4) * *(const f32x4*)(kgain + 32 * ks + 8 * fq + 4); v4u o;
                o.x = pk2(lo16(qw[ks].x) * qs * g0[0], hi16(qw[ks].x) * qs * g0[1]); o.y = pk2(lo16(qw[ks].y) * qs * g0[2], hi16(qw[ks].y) * qs * g0[3]);
                o.z = pk2(lo16(qw[ks].z) * qs * g1[0], hi16(qw[ks].z) * qs * g1[1]); o.w = pk2(lo16(qw[ks].w) * qs * g1[2], hi16(qw[ks].w) * qs * g1[3]);
                Qf[g][ks] = __builtin_bit_cast(bf16x8, o); } }
        f32x4 O[2][8]; float l[2] = {0.f, 0.f};
#pragma unroll
        for (int g = 0; g < 2; ++g)
#pragma unroll
            for (int dt = 0; dt < 8; ++dt) O[g][dt] = (f32x4){0.f, 0.f, 0.f, 0.f};
        int dbase[2]; unsigned vmask[2];
#pragma unroll
        for (int g = 0; g < 2; ++g) { const int qg = qg0 + g, c0w = (qg == 0) ? 0 : (qg == 1) ? 8 : (qg == 2) ? 24 : 32; const int qc = 16 * qg + fr, cs = min(max(qc - 8, 0), 48);
            dbase[g] = c0w + 8 * fq - qc + 15; vmask[g] = 0u;
#pragma unroll
            for (int i = 0; i < 8; ++i) { const int kc = c0w + 8 * fq + i; if (kc >= cs && kc < cs + 16) vmask[g] |= 1u << i; } }
#define NA_WRITE(buf_) do { LAS unsigned char* sn_ = stg + (buf_) * STG; \
            const float a0 = lo16(ska0.x), a1 = hi16(ska0.x), a2 = lo16(ska0.y), a3 = hi16(ska0.y), a4 = lo16(ska0.z), a5 = hi16(ska0.z), a6 = lo16(ska0.w), a7 = hi16(ska0.w); \
            const float c0 = lo16(ska1.x), c1 = hi16(ska1.x), c2 = lo16(ska1.y), c3 = hi16(ska1.y), c4 = lo16(ska1.z), c5 = hi16(ska1.z), c6 = lo16(ska1.w), c7 = hi16(ska1.w); \
            float ss_ = ((a0 * a0 + a1 * a1) + (a2 * a2 + a3 * a3)) + ((a4 * a4 + a5 * a5) + (a6 * a6 + a7 * a7)) + ((c0 * c0 + c1 * c1) + (c2 * c2 + c3 * c3)) + ((c4 * c4 + c5 * c5) + (c6 * c6 + c7 * c7)); \
            ss_ += __shfl_xor(ss_, 8); ss_ += __shfl_xor(ss_, 16); ss_ += __shfl_xor(ss_, 32); \
            const float ks_ = rsqrtf(ss_ * (1.f / 128.f) + EPS); v4u k0_, k1_; \
            k0_.x = pk2(a0 * ks_, a1 * ks_); k0_.y = pk2(a2 * ks_, a3 * ks_); k0_.z = pk2(a4 * ks_, a5 * ks_); k0_.w = pk2(a6 * ks_, a7 * ks_); \
            k1_.x = pk2(c0 * ks_, c1 * ks_); k1_.y = pk2(c2 * ks_, c3 * ks_); k1_.z = pk2(c4 * ks_, c5 * ks_); k1_.w = pk2(c6 * ks_, c7 * ks_); \
            *(LAS v4u*)(sn_ + (sc * 64 + kpos) * 16) = k0_; *(LAS v4u*)(sn_ + ((sc + 8) * 64 + kpos) * 16) = k1_; \
            *(LAS v4u*)(sn_ + KB + (sc * 128 + vpos0) * 16) = sva0; *(LAS v4u*)(sn_ + KB + (sc * 128 + vpos1) * 16) = sva1; } while (0)
#define NA_COMPUTE(st_) do { const int kr = klo + (st_); const LAS unsigned char* sb = stg + ((st_) & 1) * STG; \
            if (kr >= rs && kr <= rs + 7) { const int dr = kr - r + 7; \
                _Pragma("unroll") for (int g = 0; g < 2; ++g) { \
                    const int qg = qg0 + g, c0w = (qg == 0) ? 0 : (qg == 1) ? 8 : (qg == 2) ? 24 : 32; \
                    const int k1 = c0w + 8 * (fr >> 2) + (fr & 3), k2 = k1 + 4; \
                    const int p1 = k1 ^ (((k1 >> 4) & 1) << 2), p2 = k2 ^ (((k2 >> 4) & 1) << 2); \
                    f32x4 s1 = {0.f, 0.f, 0.f, 0.f}, s2 = {0.f, 0.f, 0.f, 0.f}; \
                    _Pragma("unroll") for (int ks = 0; ks < 4; ++ks) { const bf16x8 a1 = *(const LAS bf16x8*)(sb + ((4 * ks + fq) * 64 + p1) * 16), a2 = *(const LAS bf16x8*)(sb + ((4 * ks + fq) * 64 + p2) * 16); \
                        s1 = MFMA16(a1, Qf[g][ks], s1); s2 = MFMA16(a2, Qf[g][ks], s2); } \
                    float ps = 0.f; const LAS float* rpr = rpl + dr * 31 + dbase[g]; float bb[8]; \
                    _Pragma("unroll") for (int i = 0; i < 8; ++i) bb[i] = rpr[i]; \
                    _Pragma("unroll") for (int i = 0; i < 4; ++i) { \
                        const float x1 = __expf(s1[i] + bb[i]), x2 = __expf(s2[i] + bb[i + 4]); \
                        const float e1 = ((vmask[g] >> i) & 1u) ? x1 : 0.f, e2 = ((vmask[g] >> (i + 4)) & 1u) ? x2 : 0.f; \
                        s1[i] = e1; s2[i] = e2; ps += e1 + e2; } \
                    l[g] += ps; \
                    v4u pw; pw.x = pk2(s1[0], s1[1]); pw.y = pk2(s1[2], s1[3]); pw.z = pk2(s2[0], s2[1]); pw.w = pk2(s2[2], s2[3]); \
                    const bf16x8 Pf = __builtin_bit_cast(bf16x8, pw); \
                    const int vch = (c0w >> 3) + fq; \
                    _Pragma("unroll") for (int dt = 0; dt < 8; ++dt) { \
                        const bf16x8 av = *(const LAS bf16x8*)(sb + KB + (vch * 128 + dt * 16 + fr) * 16); O[g][dt] = MFMA16(av, Pf, O[g][dt]); } \
                } } } while (0)
        __syncthreads();
        NA_WRITE(0);
        __syncthreads();
#pragma unroll 1
        for (int st = 0; st < nst; ++st) {
            const bool more = (st + 1 < nst);
            if (more) NA_LOAD(klo + st + 1);
            NA_COMPUTE(st);
            if (more) NA_WRITE((st + 1) & 1);
            __syncthreads();
        }
#undef NA_LOAD
#undef NA_WRITE
#undef NA_COMPUTE
        { v2u bzr[2][8];
#pragma unroll
          for (int g = 0; g < 2; ++g) { const size_t qtok = (size_t)b * SEQ + r * 64 + 16 * (qg0 + g) + fr;
#pragma unroll
              for (int dt = 0; dt < 8; ++dt) bzr[g][dt] = *(const v2u*)(BZ + qtok * DM + h * BHD + dt * 16 + 4 * fq); }
          __builtin_amdgcn_sched_barrier(0);
#pragma unroll
          for (int g = 0; g < 2; ++g) { float ls = l[g]; ls += __shfl_xor(ls, 16); ls += __shfl_xor(ls, 32); const float inv = 1.f / ls;
            const size_t qtok = (size_t)b * SEQ + r * 64 + 16 * (qg0 + g) + fr;
#pragma unroll
            for (int dt = 0; dt < 8; ++dt) { const int ch = h * BHD + dt * 16 + 4 * fq; const v2u bz = bzr[g][dt];
                v2u o; o.x = pk2(O[g][dt][0] * inv * lo16(bz.x), O[g][dt][1] * inv * hi16(bz.x)); o.y = pk2(O[g][dt][2] * inv * lo16(bz.y), O[g][dt][3] * inv * hi16(bz.y));
                *(v2u*)(YC + qtok * 8192 + 4096 + ch) = o; } } }
    }
    __syncthreads();
}


constexpr int WS_HD_IS_BQK = 1;
__device__ __forceinline__ void mlstm_out_mfma(const Args& A, Frame& F) {
    const bf16* QC = (const bf16*)(A.ws + WS_QC); const bf16* VT = (const bf16*)(A.ws + WS_VT); const bf16* CT = (const bf16*)(A.ws + WS_CT);
    const float* NST = (const float*)(A.ws + WS_NST); const float* R1 = (const float*)(A.ws + WS_R1); const float* R2 = (const float*)(A.ws + WS_R2);
    bf16* HD = (bf16*)(A.ws + WS_BQK);
    LAS unsigned char* Ql = F.lds; LAS unsigned char* Kl = F.lds + 67584; LAS unsigned char* Sl = Kl;
    LAS float* r1l = (LAS float*)(F.lds + 135168); LAS float* r2l = r1l + 128; LAS float* qnl = r1l + 256; LAS float* dsl = r1l + 384;
    LAS float* nstl = r1l + 640;
    const int fr = F.lane & 15, fq = F.lane >> 4, wvv = F.tid >> 6;
    for (int u0 = F.bid; u0 < 2 * NBATCH * AH * NCHUNK; u0 += F.G) {
        int u = u0;
        if (F.G == 256) { const int i_ = u0 >> 8, x_ = u0 & 7, s_ = (u0 >> 3) & 31; u = ((i_ * 128 + x_ * 16 + (s_ >> 1)) << 1) | (s_ & 1); }
        const int dir = u & 1, j = (u >> 1) & 31, h = (u >> 6) & 7, b = u >> 9;
        const size_t m0 = (size_t)b * SEQ + j * 128; const size_t sidx = ((size_t)(dir * NBATCH + b) * AH + h) * NCHUNK + j;
        const bf16* KA = (const bf16*)(A.ws + (dir ? WS_KAB : WS_KAF));
        __syncthreads();
#pragma unroll
        for (int p = 0; p < 8; ++p) { const int e = p * NTHREADS + F.tid, row = e >> 5, ch = e & 31; const size_t go = (m0 + row) * AQKW + h * ADK + ch * 8;
            const v4u q = *(const v4u*)(QC + go), k = *(const v4u*)(KA + go);
            *(LAS v4u*)(Ql + row * 528 + ch * 16) = q; *(LAS v4u*)(Kl + row * 528 + ch * 16) = k; }
        if (F.tid < 128) { const size_t so = (size_t)(dir * NBATCH * AH + b * AH + h) * SEQ + j * 128 + F.tid; r1l[F.tid] = R1[so]; r2l[F.tid] = R2[so]; }
        else if (F.tid < 192) { const int e = F.tid - 128; *(LAS f32x4*)(nstl + 4 * e) = *(const f32x4*)(NST + sidx * ADK + 4 * e); }
        __syncthreads();
        const int vrow = wvv * 64 + 16 * (fr >> 2) + (fr & 3);
        const bf16* ctb = CT + (sidx * ADV + vrow) * ADK + 8 * fq;
        const bf16* vtb = VT + (size_t)(h * ADV + vrow) * MTOK + m0 + 8 * fq;
        bf16x8 bfr0[4];
#pragma unroll
        for (int vt = 0; vt < 4; ++vt) bfr0[vt] = *(const bf16x8*)(ctb + (size_t)(vt * 4) * ADK);
        { const int t = F.tid >> 2, part = F.tid & 3; const LAS float* nst = nstl + part * 64; float sacc_ = 0.f;
#pragma unroll
          for (int c = 0; c < 8; ++c) { const v4u w = *(const LAS v4u*)(Ql + t * 528 + part * 128 + c * 16); const f32x4 n0 = *(const LAS f32x4*)(nst + c * 8), n1 = *(const LAS f32x4*)(nst + c * 8 + 4);
              sacc_ += lo16(w.x) * n0[0] + hi16(w.x) * n0[1] + lo16(w.y) * n0[2] + hi16(w.y) * n0[3] + lo16(w.z) * n1[0] + hi16(w.z) * n1[1] + lo16(w.w) * n1[2] + hi16(w.w) * n1[3]; }
          sacc_ += __shfl_xor(sacc_, 1); sacc_ += __shfl_xor(sacc_, 2); if (part == 0) qnl[t] = sacc_; }
        f32x4 sacc[2][4];
        { const int tw = wvv >> 1, sw = wvv & 1;
#pragma unroll
          for (int a = 0; a < 2; ++a)
#pragma unroll
              for (int c = 0; c < 4; ++c) sacc[a][c] = (f32x4){0.f, 0.f, 0.f, 0.f};
#pragma unroll 2
          for (int ks = 0; ks < 8; ++ks) {
              bf16x8 qf[2], kf[4];
#pragma unroll
              for (int a = 0; a < 2; ++a) qf[a] = *(const LAS bf16x8*)(Ql + ((2 * tw + a) * 16 + fr) * 528 + (32 * ks + 8 * fq) * 2);
#pragma unroll
              for (int c = 0; c < 4; ++c) kf[c] = *(const LAS bf16x8*)(Kl + ((4 * sw + c) * 16 + fr) * 528 + (32 * ks + 8 * fq) * 2);
#pragma unroll
              for (int a = 0; a < 2; ++a)
#pragma unroll
                  for (int c = 0; c < 4; ++c) sacc[a][c] = MFMA16(kf[c], qf[a], sacc[a][c]);
          }
#pragma unroll
          for (int a = 0; a < 2; ++a) { const int t = (2 * tw + a) * 16 + fr; const float r2v = r2l[t]; float dsum = 0.f;
#pragma unroll
              for (int c = 0; c < 4; ++c)
#pragma unroll
                  for (int i = 0; i < 4; ++i) { const int sx = (4 * sw + c) * 16 + 4 * fq + i; const bool valid = dir ? (sx >= t) : (sx <= t); const float v = valid ? sacc[a][c][i] * r2v : 0.f; sacc[a][c][i] = v; dsum += v; }
              dsum += __shfl_xor(dsum, 16); dsum += __shfl_xor(dsum, 32);
              if (fq == 0) dsl[sw * 128 + t] = dsum; }
          __syncthreads();
#pragma unroll
          for (int a = 0; a < 2; ++a)
#pragma unroll
              for (int c = 0; c < 4; ++c) { v2u w; w.x = pk2(sacc[a][c][0], sacc[a][c][1]); w.y = pk2(sacc[a][c][2], sacc[a][c][3]);
                  *(LAS v2u*)(Sl + ((2 * tw + a) * 16 + fr) * 272 + ((4 * sw + c) * 16 + 4 * fq) * 2) = w; }
        }
        __syncthreads();
        bf16* hd = HD + (size_t)dir * MTOK * DM;
        {
            f32x4 acc[8][4];
#pragma unroll
            for (int tt = 0; tt < 8; ++tt)
#pragma unroll
                for (int vt = 0; vt < 4; ++vt) acc[tt][vt] = (f32x4){0.f, 0.f, 0.f, 0.f};
#define P5_STEP(B_, L_, RS_, ks_) do { _Pragma("unroll") for (int th = 0; th < 2; ++th) { bf16x8 af[4]; \
                _Pragma("unroll") for (int tt = 0; tt < 4; ++tt) af[tt] = *(const LAS bf16x8*)((L_) + ((th * 4 + tt) * 16 + fr) * (RS_) + (32 * (ks_) + 8 * fq) * 2); \
                _Pragma("unroll") for (int tt = 0; tt < 4; ++tt) _Pragma("unroll") for (int vt = 0; vt < 4; ++vt) acc[th * 4 + tt][vt] = MFMA16(B_[vt], af[tt], acc[th * 4 + tt][vt]); } } while (0)
            P5_STEP(bfr0, Ql, 528, 0);
#pragma unroll 1
            for (int ks = 1; ks < 8; ++ks) {
                bf16x8 bfr[4];
#pragma unroll
                for (int vt = 0; vt < 4; ++vt) bfr[vt] = *(const bf16x8*)(ctb + (size_t)(vt * 4) * ADK + 32 * ks);
                P5_STEP(bfr, Ql, 528, ks);
            }
#pragma unroll
            for (int tt = 0; tt < 8; ++tt) { const float r1v = r1l[tt * 16 + fr];
#pragma unroll
                for (int vt = 0; vt < 4; ++vt) acc[tt][vt] *= r1v; }
#pragma unroll 1
            for (int ks = 0; ks < 4; ++ks) {
                bf16x8 bfr[4];
#pragma unroll
                for (int vt = 0; vt < 4; ++vt) bfr[vt] = *(const bf16x8*)(vtb + (size_t)(vt * 4) * MTOK + 32 * ks);
                P5_STEP(bfr, Sl, 272, ks);
            }
#undef P5_STEP
#pragma unroll
            for (int tt = 0; tt < 8; ++tt) { const int t = tt * 16 + fr; const float den = r1l[t] * qnl[t] + dsl[t] + dsl[128 + t]; const float inv = 1.f / fmaxf(fabsf(den), 1.0f);
                bf16* hp = hd + (m0 + t) * DM + h * ADV + wvv * 64 + 16 * fq;
                v4u w0, w1;
                w0.x = pk2(acc[tt][0][0] * inv, acc[tt][0][1] * inv); w0.y = pk2(acc[tt][0][2] * inv, acc[tt][0][3] * inv); w0.z = pk2(acc[tt][1][0] * inv, acc[tt][1][1] * inv); w0.w = pk2(acc[tt][1][2] * inv, acc[tt][1][3] * inv);
                w1.x = pk2(acc[tt][2][0] * inv, acc[tt][2][1] * inv); w1.y = pk2(acc[tt][2][2] * inv, acc[tt][2][3] * inv); w1.z = pk2(acc[tt][3][0] * inv, acc[tt][3][1] * inv); w1.w = pk2(acc[tt][3][2] * inv, acc[tt][3][3] * inv);
                *(v4u*)hp = w0; *(v4u*)(hp + 8) = w1; }
        }
    }
    __syncthreads();
}
__device__ __forceinline__ void mlstm_combine(const Args& A, Frame& F) {
    const bf16* HD0 = (const bf16*)(A.ws + WS_BQK); const bf16* HD1 = HD0 + (size_t)MTOK * DM; const bf16* GA = (const bf16*)(A.ws + WS_GA); bf16* YC = (bf16*)(A.ws + WS_YCAT);
    const int gw = F.bid * NWAVES + F.wave, NGW = F.G * NWAVES;
    const int h = gw & 7;
    const f32x4 g0 = *(const f32x4*)(A.in[8] + h * ADV + F.lane * 8), g1 = *(const f32x4*)(A.in[8] + h * ADV + F.lane * 8 + 4);
    v4u a0[4], c0[4], q0[4], a1[4], c1[4], q1[4];
#define MC_LOAD(a_, c_, q_, it_) do { _Pragma("unroll") for (int k = 0; k < 4; ++k) { const int i_ = (it_) + k * NGW; if (i_ < MTOK * AH) { const size_t off = (size_t)(i_ >> 3) * DM + h * ADV + F.lane * 8; \
            a_[k] = *(const v4u*)(HD0 + off); c_[k] = *(const v4u*)(HD1 + off); q_[k] = *(const v4u*)(GA + off); } } } while (0)
#define MC_PROC(a_, c_, q_, it_) do { _Pragma("unroll") for (int k = 0; k < 4; ++k) { const int i_ = (it_) + k * NGW; if (i_ < MTOK * AH) { const v4u a = a_[k], c = c_[k], g = q_[k]; \
            float x[8] = {lo16(a.x) + lo16(c.x), hi16(a.x) + hi16(c.x), lo16(a.y) + lo16(c.y), hi16(a.y) + hi16(c.y), lo16(a.z) + lo16(c.z), hi16(a.z) + hi16(c.z), lo16(a.w) + lo16(c.w), hi16(a.w) + hi16(c.w)}; \
            float ss = 0.f; _Pragma("unroll") for (int i = 0; i < 8; ++i) ss += x[i] * x[i]; \
            const float rstd = rsqrtf(wave_sum(ss) * (1.f / ADV) + EPS); \
            v4u o; o.x = pk2(x[0] * rstd * g0[0] * lo16(g.x), x[1] * rstd * g0[1] * hi16(g.x)); o.y = pk2(x[2] * rstd * g0[2] * lo16(g.y), x[3] * rstd * g0[3] * hi16(g.y)); \
            o.z = pk2(x[4] * rstd * g1[0] * lo16(g.z), x[5] * rstd * g1[1] * hi16(g.z)); o.w = pk2(x[6] * rstd * g1[2] * lo16(g.w), x[7] * rstd * g1[3] * hi16(g.w)); \
            *(v4u*)(YC + (size_t)(i_ >> 3) * 8192 + h * ADV + F.lane * 8) = o; } } } while (0)
    MC_LOAD(a0, c0, q0, gw);
#pragma unroll 1
    for (int it = gw; it < MTOK * AH; it += 8 * NGW) {
        MC_LOAD(a1, c1, q1, it + 4 * NGW); __builtin_amdgcn_sched_barrier(0);
        MC_PROC(a0, c0, q0, it); __builtin_amdgcn_sched_barrier(0);
        MC_LOAD(a0, c0, q0, it + 8 * NGW); __builtin_amdgcn_sched_barrier(0);
        MC_PROC(a1, c1, q1, it + 4 * NGW); __builtin_amdgcn_sched_barrier(0);
    }
#undef MC_LOAD
#undef MC_PROC
}


__device__ __forceinline__ void sgu_mfma(const Args& A, Frame& F) {
    const bf16* GVT = (const bf16*)(A.ws + WS_GVT); const bf16* UZ = (const bf16*)(A.ws + WS_UZ); const float* VSS = (const float*)(A.ws + WS_VSS);
    bf16* Y1 = (bf16*)(A.ws + WS_Y1);
    LAS unsigned char* Wl = F.lds;
    LAS float* rs = (LAS float*)(F.lds + 32768);
    LAS float* rp = rs + 128;
    const int fr = F.lane & 15, fq = F.lane >> 4, wvv = F.tid >> 6;
    const float* cws = A.in[18]; const float* cbs = A.in[19]; const float* cg = A.in[17];
    for (int u = F.bid; u < NBATCH * NCHUNK * 2; u += F.G) {
        const int b = u >> 6, n = (u >> 1) & 31, gh = u & 1; const size_t m0 = (size_t)b * SEQ + n * 128;
        __syncthreads();
        { const int s = F.tid & 127, part = F.tid >> 7; float a = 0.f;
#pragma unroll
          for (int p = 0; p < 16; ++p) a += VSS[(size_t)(part * 16 + p) * MTOK + m0 + s];
          rp[part * 128 + s] = a; }
        __syncthreads();
        if (F.tid < 128) rs[F.tid] = rsqrtf((rp[F.tid] + rp[128 + F.tid] + rp[256 + F.tid] + rp[384 + F.tid]) * (1.f / CWID) + EPS);
#pragma unroll 1
        for (int gi = 0; gi < 4; ++gi) {
            const int g = gh * 4 + gi;
            __syncthreads();
#pragma unroll
            for (int it = 0; it < 4; ++it) { const int idx = it * NTHREADS + F.tid, t = idx & 127, c = idx >> 7; const float* wp = cws + (size_t)g * 16384 + t * 128 + c * 8;
                const f32x4 w0 = *(const f32x4*)wp, w1 = *(const f32x4*)(wp + 4); const f32x4 r0 = *(const LAS f32x4*)(rs + c * 8), r1 = *(const LAS f32x4*)(rs + c * 8 + 4);
                v4u o; o.x = pk2(w0[0] * r0[0], w0[1] * r0[1]); o.y = pk2(w0[2] * r0[2], w0[3] * r0[3]); o.z = pk2(w1[0] * r1[0], w1[1] * r1[1]); o.w = pk2(w1[2] * r1[2], w1[3] * r1[3]);
                *(LAS v4u*)(Wl + (c * 128 + t) * 16) = o; }
            __syncthreads();
#pragma unroll 1
            for (int q = 0; q < 2; ++q) {
                const int ch0 = g * CGC + (wvv * 2 + q) * 64;
                const bf16* ap = GVT + (size_t)(ch0 + 16 * (fr >> 2) + (fr & 3)) * MTOK + m0 + 8 * fq;
                bf16x8 Af[4][4];
#pragma unroll
                for (int ct = 0; ct < 4; ++ct)
#pragma unroll
                    for (int ks = 0; ks < 4; ++ks) Af[ct][ks] = *(const bf16x8*)(ap + (size_t)(4 * ct) * MTOK + 32 * ks);
                const int chb = ch0 + 16 * fq;
                f32x4 gn[4];
#pragma unroll
                for (int ct = 0; ct < 4; ++ct) gn[ct] = *(const f32x4*)(cg + chb + 4 * ct);
                v4u uzr[8][2]; float bsr[8];
#pragma unroll
                for (int tt = 0; tt < 8; ++tt) { const size_t off = (m0 + tt * 16 + fr) * CWID + chb; uzr[tt][0] = *(const v4u*)(UZ + off); uzr[tt][1] = *(const v4u*)(UZ + off + 8); bsr[tt] = cbs[g * 128 + tt * 16 + fr]; }
                __builtin_amdgcn_sched_barrier(0);
#pragma unroll
                for (int tt = 0; tt < 8; ++tt) {
                    const int t = tt * 16 + fr; const size_t off = (m0 + t) * CWID + chb;
                    const v4u uz0 = uzr[tt][0], uz1 = uzr[tt][1];
                    const float bias = bsr[tt];
                    bf16x8 Bf[4];
#pragma unroll
                    for (int ks = 0; ks < 4; ++ks) Bf[ks] = *(const LAS bf16x8*)(Wl + ((4 * ks + fq) * 128 + t) * 16);
                    f32x4 acc[4];
#pragma unroll
                    for (int ct = 0; ct < 4; ++ct) { acc[ct] = (f32x4){0.f, 0.f, 0.f, 0.f};
#pragma unroll
                        for (int ks = 0; ks < 4; ++ks) acc[ct] = MFMA16(Af[ct][ks], Bf[ks], acc[ct]); }
                    const unsigned uw[8] = {uz0.x, uz0.y, uz0.z, uz0.w, uz1.x, uz1.y, uz1.z, uz1.w};
                    unsigned ow[8];
#pragma unroll
                    for (int ct = 0; ct < 4; ++ct) {
                        ow[2 * ct] = pk2(lo16(uw[2 * ct]) * (gn[ct][0] * acc[ct][0] + bias), hi16(uw[2 * ct]) * (gn[ct][1] * acc[ct][1] + bias));
                        ow[2 * ct + 1] = pk2(lo16(uw[2 * ct + 1]) * (gn[ct][2] * acc[ct][2] + bias), hi16(uw[2 * ct + 1]) * (gn[ct][3] * acc[ct][3] + bias)); }
                    v4u o0, o1; o0.x = ow[0]; o0.y = ow[1]; o0.z = ow[2]; o0.w = ow[3]; o1.x = ow[4]; o1.y = ow[5]; o1.z = ow[6]; o1.w = ow[7];
                    *(v4u*)(Y1 + off) = o0; *(v4u*)(Y1 + off + 8) = o1;
                }
            }
        }
    }
    __syncthreads();
}

__global__ void __launch_bounds__(NTHREADS, 2) mk_fwd(Args A) {
    extern __shared__ __attribute__((aligned(16))) unsigned char lds[];
    Frame F;
    F.lds = (LAS unsigned char*)lds; F.tid = threadIdx.x; F.lane = F.tid & 63; F.wave = __builtin_amdgcn_readfirstlane(F.tid >> 6); F.G = gridDim.x; F.bid = blockIdx.x;
    volatile LAS unsigned* MISC = (volatile LAS unsigned*)(F.lds + MISC_OFF);
    if (F.tid < 64) MISC[F.tid] = 0u;
    __syncthreads();
    XcdBarrier bar; bar.bar = (unsigned*)(A.ws + WS_CTL) + CW_BAR; bar.x = 0; bar.st = nullptr;
    if (N_LAUNCHES == 1) bar = xcd_barrier_post((unsigned*)(A.ws + WS_CTL) + CW_BAR, MISC + 8);
    const int lo = A.ph_lo, hi = A.ph_hi;
#define IN(k) (lo <= (k) && (k) < hi)
#define SEAM(k) do { if (IN(k) && IN((k) + 1)) xcd_barrier(bar); } while (0)
#ifndef DBL_MASK
#define DBL_MASK 0u
#endif
#define REP(k) _Pragma("unroll") for (int rep_ = 0; rep_ <= (int)((DBL_MASK >> (k)) & 1u); ++rep_)
#define REPB() do { if (rep_) xcd_barrier(bar); } while (0)
    float* mod0 = (float*)(A.ws + WS_MOD); float* mod1 = mod0 + 4 * 12288;
    bf16* H = (bf16*)(A.ws + WS_H);
    LAS unsigned char* ring = F.lds;

    if (IN(0)) { REP(16) { ada_items(A, F, rep_); } REP(14) { REPB(); p0_prep(A, F); } } SEAM(0);
    if ((DBL_MASK >> 18) & 1u) { for (int xb_ = 0; xb_ < 20; ++xb_) xcd_barrier(bar); }
    if (IN(1)) REP(1) { REPB(); norm_rows<false>(A, F, A.in[0], A.in[2], mod0, A.in[4], H); } SEAM(1);
    if (IN(2)) REP(2) { REPB();
        gates_mfma(A, F);
        const bf16* W0A = (const bf16*)(A.ws + WS_W0A);
        { pg8::Gemm g{H, W0A, MTOK, 4096, DM}; pg8::StaticOrder S; S.init(MTOK, 4096, F.G, F.bid); pg8::EpiStore<0> E{(bf16*)(A.ws + WS_QKRAW), DM};
          pg8::gemm_phase<pg8::EpiStore<0>, pg8::StaticOrder, true, true>(ring, g, S, E); }
        { pg8::Gemm g{H, W0A + (size_t)4096 * DM, MTOK, 8192, DM}; pg8::StaticOrder S; S.init(MTOK, 8192, F.G, F.bid); pg8::EpiPair<0> E{(bf16*)(A.ws + WS_GA), DM};
          pg8::gemm_phase<pg8::EpiPair<0>, pg8::StaticOrder, true, true>(ring, g, S, E); }
        { pg8::Gemm g{H, W0A + (size_t)12288 * DM, MTOK, 8192, DM}; pg8::StaticOrder S; S.init(MTOK, 8192, F.G, F.bid); pg8::EpiStore<0> E{(bf16*)(A.ws + WS_BQK), 8192};
          pg8::gemm_phase<pg8::EpiStore<0>, pg8::StaticOrder, true, true>(ring, g, S, E); }
        { pg8::Gemm g{H, W0A + (size_t)20480 * DM, MTOK, 4096, DM}; pg8::StaticOrder S; S.init(MTOK, 4096, F.G, F.bid); pg8::EpiStore<1> E{(bf16*)(A.ws + WS_BZ), DM};
          pg8::gemm_phase<pg8::EpiStore<1>, pg8::StaticOrder, true, true>(ring, g, S, E); }
        { pg8::Gemm g{(const bf16*)(A.ws + WS_W0V), H, 8192, MTOK, DM}; pg8::HybridOrder S; S.init(8192, MTOK, F.G, F.bid); S.ns = 5; S.head = (unsigned*)(A.ws + WS_CTL) + CW_QUEUE + 0 * 64; S.slot = (volatile LAS int*)(MISC + 16); pg8::EpiStore<0> E{(bf16*)(A.ws + WS_VT), MTOK};
          pg8::gemm_phase<pg8::EpiStore<0>, pg8::HybridOrder, true, true>(ring, g, S, E); }
    } SEAM(2);
    if (IN(3)) { REP(15) { REPB(); mid_opt(A, F); } }     SEAM(3);
    if (IN(4)) { REP(12) { REPB(); scan_mfma(A, F); } REP(13) { REPB(); natten_lds(A, F); } } SEAM(4);
    if (IN(5)) REP(5) { REPB(); mlstm_out_mfma(A, F); } SEAM(5);
    if (IN(6)) REP(6) { REPB(); mlstm_combine(A, F); } SEAM(6);
    if (IN(7)) REP(7) { REPB();
        pg8::Gemm g{(const bf16*)(A.ws + WS_YCAT), (const bf16*)(A.ws + WS_WOUT0), MTOK, DM, 8192}; pg8::StaticOrder S; S.init(MTOK, DM, F.G, F.bid);
        pg8::EpiResid<false, true> E{A.in[0], (void*)(A.ws + WS_X1), DM, mod0, A.in[4], SEQ};
        pg8::gemm_phase<pg8::EpiResid<false, true>, pg8::StaticOrder, true, true>(ring, g, S, E);
    } SEAM(7);
    if (IN(8)) REP(8) { REPB(); p7_prep1(A, F); norm_rows<true>(A, F, (const void*)(A.ws + WS_X1), A.in[13], mod1, A.in[15], H); } SEAM(8);
    if (IN(9)) REP(9) { REPB();
#ifdef PROBE_CU192
        const int r192 = F.bid >> 3; const bool act192 = (r192 & 3) != 3; const int c192 = (r192 - (r192 >> 2)) * 8 + (F.bid & 7);
        if (act192) {
        { pg8::Gemm g{H, (const bf16*)(A.ws + WS_W1A), MTOK, 16384, DM}; pg8::StaticOrder S; S.init(MTOK, 16384, 192, c192); pg8::EpiPair<1> E{(bf16*)(A.ws + WS_UZ), CWID};
          pg8::gemm_phase<pg8::EpiPair<1>, pg8::StaticOrder, true, true>(ring, g, S, E); }
        { pg8::Gemm g{(const bf16*)(A.ws + WS_W1V), H, 8192, MTOK, DM}; pg8::StaticOrder S; S.init(8192, MTOK, 192, c192); pg8::EpiGeluT E{(bf16*)(A.ws + WS_GVT), MTOK, (float*)(A.ws + WS_VSS), MTOK};
          pg8::gemm_phase<pg8::EpiGeluT, pg8::StaticOrder, true, true>(ring, g, S, E); }
        }
        if (false) {
#else
        {
#endif
        { pg8::Gemm g{H, (const bf16*)(A.ws + WS_W1A), MTOK, 16384, DM}; pg8::StaticOrder S; S.init(MTOK, 16384, F.G, F.bid); pg8::EpiPair<1> E{(bf16*)(A.ws + WS_UZ), CWID};
          pg8::gemm_phase<pg8::EpiPair<1>, pg8::StaticOrder, true, true>(ring, g, S, E); }
        { pg8::Gemm g{(const bf16*)(A.ws + WS_W1V), H, 8192, MTOK, DM}; pg8::HybridOrder S; S.init(8192, MTOK, F.G, F.bid); S.ns = 5; S.head = (unsigned*)(A.ws + WS_CTL) + CW_QUEUE + 1 * 64; S.slot = (volatile LAS int*)(MISC + 16); pg8::EpiGeluT E{(bf16*)(A.ws + WS_GVT), MTOK, (float*)(A.ws + WS_VSS), MTOK};
          pg8::gemm_phase<pg8::EpiGeluT, pg8::HybridOrder, true, true>(ring, g, S, E); }
        }
    } SEAM(9);
    if (IN(10)) REP(10) { REPB(); sgu_mfma(A, F); } SEAM(10);
    if (IN(11)) REP(11) { REPB();
        pg8::Gemm g{(const bf16*)(A.ws + WS_Y1), (const bf16*)(A.ws + WS_WOUT1), MTOK, DM, 8192}; pg8::StaticOrder S; S.init(MTOK, DM, F.G, F.bid);
        pg8::EpiResid<true, false> E{(const void*)(A.ws + WS_X1), (void*)A.out, DM, mod1, A.in[15], SEQ};
        pg8::gemm_phase<pg8::EpiResid<true, false>, pg8::StaticOrder, true, true>(ring, g, S, E);
    }
#undef IN
#undef SEAM
}

extern "C" void kernel_launch(void* const* d_in, const int* in_sizes, int n_in, void* d_out, int out_size, void* d_ws, size_t ws_size, hipStream_t stream) {
    static int grid = 0;
    if (grid == 0) {
        if (n_in != 21 || out_size != MTOK * DM || ws_size < WS_NEED) { fprintf(stderr, "kernel_launch: unexpected shapes (n_in %d, out %d, ws %zu, need %zu); nothing launched\n", n_in, out_size, ws_size, (size_t)WS_NEED); grid = -1; return; }
        int dev = 0, cus = 0, per_cu = 0;
        if (hipGetDevice(&dev) != hipSuccess || hipDeviceGetAttribute(&cus, hipDeviceAttributeMultiprocessorCount, dev) != hipSuccess) { grid = -1; return; }
        if (hipFuncSetAttribute((const void*)mk_fwd, hipFuncAttributeMaxDynamicSharedMemorySize, LDS_BYTES) != hipSuccess) { fprintf(stderr, "kernel_launch: hipFuncSetAttribute failed\n"); grid = -1; return; }
        if (hipOccupancyMaxActiveBlocksPerMultiprocessor(&per_cu, (const void*)mk_fwd, NTHREADS, LDS_BYTES) != hipSuccess || per_cu < 1) { fprintf(stderr, "kernel_launch: occupancy query says %d\n", per_cu); }
        (void)hipGetLastError();
        grid = cus;
    }
    if (grid < 0) return;
    if (hipMemsetAsync((char*)d_ws + WS_CTL, 0, CTL_ZERO_BYTES, stream) != hipSuccess) return;
    Args a{};
    for (int i = 0; i < 21; ++i) a.in[i] = (const float*)d_in[i];
    a.out = (float*)d_out; a.ws = (unsigned char*)d_ws;
    for (int li = 0; li < N_LAUNCHES; ++li) {
        a.ph_lo = (N_LAUNCHES == 1) ? 0 : li; a.ph_hi = (N_LAUNCHES == 1) ? NPHASE : li + 1;
        hipLaunchKernelGGL(mk_fwd, dim3(grid), dim3(NTHREADS), LDS_BYTES, stream, a);
        if (hipPeekAtLastError() != hipSuccess) { fprintf(stderr, "kernel_launch: launch %d failed\n", li); break; }
    }
}
```
